# Optimizing an MI355X kernel written in HIP

```python
import math
import jax, jax.numpy as jnp
from jax import lax
import numpy as np

D_MODEL = 1024
BATCH = 32
SEQ = 2048
DEPTH = 1

GLA_HEADS = 4
GLA_DK = 64
GLA_DV = 128
GLA_RANK = 16
GLA_CHUNK = 64
GLA_GATE_NORM = 16.0
SWA_HEADS = 8
SWA_KV_HEADS = 2
SWA_HD = 64
SWA_WINDOW = 128
SWA_BLOCK = 128
N_BRANCH = 2

GLA_QK_W = GLA_HEADS * GLA_DK
GLA_V_W = GLA_HEADS * GLA_DV
SWA_Q_W = SWA_HEADS * SWA_HD
SWA_KV_W = SWA_KV_HEADS * SWA_HD
IN_SPLITS = (GLA_QK_W, GLA_QK_W, GLA_V_W, GLA_RANK, GLA_V_W, SWA_Q_W, SWA_KV_W, SWA_KV_W, SWA_Q_W, N_BRANCH * D_MODEL)
D_IN = 4880
DEEPNORM_ALPHA = (2.0 * DEPTH) ** 0.25
DEEPNORM_BETA = (8.0 * DEPTH) ** -0.25
LN_EPS = 1e-5
RMS_EPS = 1e-6

kernel_name = "hybrid_gla_swa_sink_alibi_deepnorm"


def _alibi_slopes(n):
    return 2.0 ** (-8.0 * jnp.arange(1, n + 1, dtype=jnp.float32) / n)


def _gla(q, k, v, log_g):
    B, S, H, DK = q.shape
    DV = v.shape[-1]
    L = GLA_CHUNK
    C = S // L
    q = q.reshape(B, C, L, H, DK) * (DK ** -0.5)
    k = k.reshape(B, C, L, H, DK)
    v = v.reshape(B, C, L, H, DV)
    G = lax.cumsum(log_g.reshape(B, C, L, H, DK), axis=2)
    G_last = G[:, :, -1]
    q_dec = q * jnp.exp(G)
    k_inv = k * jnp.exp(-G)
    causal = jnp.tril(jnp.ones((L, L), dtype=bool))
    A = jnp.einsum('bclhd,bcmhd->bchlm', q_dec, k_inv)
    A = jnp.where(causal, A, 0.0)
    o_intra = jnp.einsum('bchlm,bcmhv->bclhv', A, v)
    k_to_end = k * jnp.exp(G_last[:, :, None] - G)
    kv = jnp.einsum('bclhd,bclhv->cbhdv', k_to_end, v)
    decay = jnp.exp(G_last).transpose(1, 0, 2, 3)

    def step(state, inp):
        d, kv_c = inp
        return state * d[..., None] + kv_c, state

    s0 = jnp.zeros((B, H, DK, DV), dtype=q.dtype)
    _, s_prev = lax.scan(step, s0, (decay, kv))
    o_inter = jnp.einsum('bclhd,cbhdv->bclhv', q_dec, s_prev)
    return (o_intra + o_inter).reshape(B, S, H, DV)


def _swa_sink_alibi(q, k, v, sinks):
    B, S, H, D = q.shape
    KV = k.shape[2]
    G = H // KV
    W = SWA_BLOCK
    N = S // W
    qb = q.reshape(B, N, W, KV, G, D)
    pad = ((0, 0), (W, 0), (0, 0), (0, 0))
    kp = jnp.pad(k, pad).reshape(B, N + 1, W, KV, D)
    vp = jnp.pad(v, pad).reshape(B, N + 1, W, KV, D)
    kb = jnp.concatenate([kp[:, :-1], kp[:, 1:]], axis=2)
    vb = jnp.concatenate([vp[:, :-1], vp[:, 1:]], axis=2)
    scores = jnp.einsum('bnqkgd,bnskd->bnkgqs', qb, kb).astype(jnp.float32) * (D ** -0.5)
    q_pos = jnp.arange(N)[:, None] * W + jnp.arange(W)[None, :]
    k_pos = (jnp.arange(N)[:, None] - 1) * W + jnp.arange(2 * W)[None, :]
    dist = q_pos[:, :, None] - k_pos[:, None, :]
    valid = (dist >= 0) & (dist < SWA_WINDOW) & (k_pos[:, None, :] >= 0)
    slopes = _alibi_slopes(H).reshape(KV, G)
    scores = scores - slopes[None, None, :, :, None, None] * dist.astype(jnp.float32)[None, :, None, None]
    scores = jnp.where(valid[None, :, None, None], scores, -jnp.inf)
    sink = jnp.broadcast_to(sinks.astype(jnp.float32).reshape(1, 1, KV, G, 1, 1), scores.shape[:-1] + (1,))
    probs = jax.nn.softmax(jnp.concatenate([scores, sink], axis=-1), axis=-1)[..., :-1]
    out = jnp.einsum('bnkgqs,bnskd->bnqkgd', probs.astype(v.dtype), vb)
    return out.reshape(B, S, H * D)


def _mixer(x, w_in, w_gk2, b_gk, gla_norm_g, w_o_gla, sinks, w_o_swa, b_gate, w_out):
    B, S, _ = x.shape
    h = x @ w_in
    idx = tuple(int(i) for i in np.cumsum(IN_SPLITS)[:-1])
    q_g, k_g, v_g, gk_lr, z_g, q_s, k_s, v_s, z_s, gate_logits = jnp.split(h, idx, axis=-1)

    log_g = jax.nn.log_sigmoid((gk_lr @ w_gk2 + b_gk).astype(jnp.float32)) / GLA_GATE_NORM
    o = _gla(q_g.astype(jnp.float32).reshape(B, S, GLA_HEADS, GLA_DK),
             k_g.astype(jnp.float32).reshape(B, S, GLA_HEADS, GLA_DK),
             v_g.astype(jnp.float32).reshape(B, S, GLA_HEADS, GLA_DV),
             log_g.reshape(B, S, GLA_HEADS, GLA_DK))
    o = o * lax.rsqrt(jnp.mean(o * o, axis=-1, keepdims=True) + RMS_EPS) * gla_norm_g.astype(jnp.float32)
    y_gla = (o.reshape(B, S, GLA_V_W).astype(x.dtype) * jax.nn.silu(z_g)) @ w_o_gla

    o_s = _swa_sink_alibi(q_s.reshape(B, S, SWA_HEADS, SWA_HD),
                          k_s.reshape(B, S, SWA_KV_HEADS, SWA_HD),
                          v_s.reshape(B, S, SWA_KV_HEADS, SWA_HD), sinks)
    y_swa = (o_s * jax.nn.silu(z_s)) @ w_o_swa

    gates = jax.nn.sigmoid(gate_logits + b_gate)
    g_a, g_b = jnp.split(gates, 2, axis=-1)
    return (g_a * y_gla + g_b * y_swa) @ w_out


def setup_inputs(seed: int = 0) -> dict:
    key = jax.random.key(seed)
    ks = jax.random.split(key, 12)
    beta = DEEPNORM_BETA
    col_scales = (1.0, 1.0, beta, 1.0, 1.0, 1.0, 1.0, beta, 1.0, 1.0)
    col_scale = jnp.concatenate([jnp.full((n,), s, dtype=jnp.float32) for n, s in zip(IN_SPLITS, col_scales)])
    x = jax.random.normal(ks[0], (BATCH, SEQ, D_MODEL), jnp.float32)
    w_in = jax.random.normal(ks[1], (D_MODEL, D_IN), jnp.float32) * (D_MODEL ** -0.5) * col_scale
    w_gk2 = jax.random.normal(ks[2], (GLA_RANK, GLA_QK_W), jnp.float32) * (GLA_RANK ** -0.5)
    b_gk = 0.01 * jax.random.normal(ks[3], (GLA_QK_W,), jnp.float32)
    gla_norm_g = 1.0 + 0.02 * jax.random.normal(ks[4], (GLA_DV,), jnp.float32)
    w_o_gla = jax.random.normal(ks[5], (GLA_V_W, D_MODEL), jnp.float32) * (GLA_V_W ** -0.5) * beta
    sinks = 0.5 * jax.random.normal(ks[6], (SWA_HEADS,), jnp.float32)
    w_o_swa = jax.random.normal(ks[7], (SWA_Q_W, D_MODEL), jnp.float32) * (SWA_Q_W ** -0.5) * beta
    b_gate = 0.01 * jax.random.normal(ks[8], (N_BRANCH * D_MODEL,), jnp.float32)
    w_out = jax.random.normal(ks[9], (D_MODEL, D_MODEL), jnp.float32) * (D_MODEL ** -0.5) * beta
    ln_g = 1.0 + 0.02 * jax.random.normal(ks[10], (D_MODEL,), jnp.float32)
    ln_b = 0.02 * jax.random.normal(ks[11], (D_MODEL,), jnp.float32)
    return {"x": x, "w_in": w_in, "w_gk2": w_gk2, "b_gk": b_gk, "gla_norm_g": gla_norm_g,
            "w_o_gla": w_o_gla, "sinks": sinks, "w_o_swa": w_o_swa, "b_gate": b_gate,
            "w_out": w_out, "ln_g": ln_g, "ln_b": ln_b}


def reference(x, w_in, w_gk2, b_gk, gla_norm_g, w_o_gla, sinks, w_o_swa, b_gate, w_out, ln_g, ln_b):
    for _ in range(DEPTH):
        y = _mixer(x, w_in, w_gk2, b_gk, gla_norm_g, w_o_gla, sinks, w_o_swa, b_gate, w_out)
        r = (DEEPNORM_ALPHA * x + y).astype(jnp.float32)
        mu = jnp.mean(r, axis=-1, keepdims=True)
        var = jnp.mean(jnp.square(r - mu), axis=-1, keepdims=True)
        x = ((r - mu) * lax.rsqrt(var + LN_EPS) * ln_g.astype(jnp.float32) + ln_b.astype(jnp.float32)).astype(x.dtype)
    return x
```

```cpp
#include <hip/hip_runtime.h>
#include <cstdio>
#include <cstdint>
namespace pg8 {
#define PG8_LAS __attribute__((address_space(3)))
typedef unsigned short bf16_t;
typedef short bf16x8 __attribute__((ext_vector_type(8)));
typedef float f32x4 __attribute__((ext_vector_type(4)));
typedef unsigned u32x4 __attribute__((ext_vector_type(4)));
constexpr int BM = 256, BK = 64, HALF = 128, HTB = HALF * BK * 2  , STAGE_BYTES = 8 * HTB, NXCD = 8, WGM = 2;

__host__ __device__ __forceinline__ int lds_byte(int r, int c) { const int st = (r >> 4) * 2 + (c >> 5), rr = r & 15, cc = c & 31, ob = rr * 64 + cc * 2; return st * 1024 + (ob ^ (((ob >> 9) & 1) << 5)); }
__host__ __device__ __forceinline__ void stage_rc(int b, int& R, int& C) { const int st = b / 1024, sb = b % 1024, swz = sb ^ (((sb >> 9) & 1) << 5); R = (st >> 1) * 16 + swz / 64; C = (st & 1) * 32 + (swz % 64) / 2; }
__host__ __device__ __forceinline__ int perm32(int rho) { const int n = rho >> 4, i = rho & 15; return 8 * (i >> 2) + 4 * n + (i & 3); }

struct Unit { int pm, pn, pb, acol; };
struct Gemm { const bf16_t* A; const bf16_t* Bt; int lda, ldb, K; };

template <int WGM_ = WGM>
__host__ __device__ __forceinline__ void tile_of(int L, int nM, int nN, int& pm, int& pn) {
    const int nwg = nM * nN; int wgid = L; { const int q = nwg / NXCD, r = nwg % NXCD, xcd = wgid % NXCD, off = wgid / NXCD; wgid = (xcd < r ? xcd * (q + 1) : r * (q + 1) + (xcd - r) * q) + off; }
    const int nig = WGM_ * nN, gid = wgid / nig, fm = gid * WGM_, gsz = (nM - fm) < WGM_ ? (nM - fm) : WGM_;
    pm = fm + ((wgid % nig) % gsz); pn = (wgid % nig) / gsz;
}
struct StaticOrder {
    int nM, nN, nwg, G, c;
    __host__ __device__ void init(int M, int N, int G_, int c_) { nM = M / BM; nN = N / BM; nwg = nM * nN; G = G_; c = c_; }
    __host__ __device__ bool next(int i, Unit& u) const {
        const long L = (long)i * G + c; if (L >= nwg) return false;
        tile_of((int)L, nM, nN, u.pm, u.pn); u.pb = u.pn; u.acol = 0; return true;
    }
    __device__ __forceinline__ void a_ready(const Unit&) const {}
    __device__ __forceinline__ void done(const Unit&) const {}
};
constexpr int P1_WGM = 1;
struct SkipOrder {
    int nM, nN, nwg, G, c, skip;
    __host__ __device__ void init(int M, int N, int G_, int c_, int skip_) { nM = M / BM; nN = N / BM - 1; nwg = nM * nN; G = G_; c = c_; skip = skip_; }
    __host__ __device__ bool next(int i, Unit& u) const {
        const long L = (long)i * G + c; if (L >= nwg) return false;
        tile_of<P1_WGM>((int)L, nM, nN, u.pm, u.pn); if (u.pn >= skip) ++u.pn; u.pb = u.pn; u.acol = 0; return true;
    }
    __device__ __forceinline__ void a_ready(const Unit&) const {}
    __device__ __forceinline__ void done(const Unit&) const {}
};
struct PairOrder {
    int nM, nN, nwg, G, c;
    __host__ __device__ void init(int M, int N, int G_, int c_) { nM = M / BM; nN = N / BM; nwg = nM * nN; G = G_; c = c_; }
    __host__ __device__ bool next(int i, Unit& u) const {
        const long L = (long)(i >> 1) * G + c; if (L >= nwg) return false;
        tile_of((int)L, nM, nN, u.pm, u.pn); const int which = i & 1; u.pb = 2 * u.pn + which; u.acol = which * 512 * 2; return true;
    }
    __device__ __forceinline__ void a_ready(const Unit&) const {}
    __device__ __forceinline__ void done(const Unit&) const {}
};

typedef float f32x2_t __attribute__((ext_vector_type(2))); typedef __bf16 bf16x2_t __attribute__((ext_vector_type(2)));
__device__ __forceinline__ unsigned cvt_pk_bf16(float lo, float hi) { f32x2_t v = {lo, hi}; bf16x2_t b = __builtin_convertvector(v, bf16x2_t); return __builtin_bit_cast(unsigned, b); }
__device__ __forceinline__ float bf_lo(unsigned w) { return __uint_as_float(w << 16); }
__device__ __forceinline__ float bf_hi(unsigned w) { return __uint_as_float(w & 0xffff0000u); }
constexpr float LOG2E = 1.4426950408889634f;
__device__ __forceinline__ float t_sigmoid(float v) { return __builtin_amdgcn_rcpf(1.f + __builtin_amdgcn_exp2f(-v * LOG2E)); }
__device__ __forceinline__ float t_silu(float v) { return v * t_sigmoid(v); }
__device__ __forceinline__ float t_lg2(float z) {
    const float a = __builtin_fabsf(z) * LOG2E;
    const float l = __builtin_amdgcn_logf(1.f + __builtin_amdgcn_exp2f(-a));
    return (__builtin_fminf(z, 0.f) * LOG2E - l) * 0.0625f;
}

constexpr int SH_N = 256, SH_KS = 0, SH_VS = 128;
constexpr int HC_QG = 0, HC_KG = 256, HC_LG = 512, HC_VG = 768, HC_ZG = 1280, HC_QS = 1792, HC_KS = 2304, HC_VS = 2432, HC_ZS = 2560, HC_GA = 3072, HC_GB = 4096, HN = 3072, NP1 = 5120;
constexpr int EPI_BUF0 = 3 * HTB, EPI_BUF1 = STAGE_BYTES + 1024;
template <class P>
__device__ __forceinline__ void staged_rows_bf16(PG8_LAS unsigned char* lds, bf16_t* tile, size_t ld, int wr, int wc, int fr, int fq, int wid, int lane, const P& piece) {
    asm volatile("" : "+v"(lane), "+v"(fr), "+v"(fq));
#pragma unroll
    for (int rr = 0; rr < 8; ++rr) { const int ai = rr >> 2, m = rr & 3; PG8_LAS unsigned char* buf = lds + ((rr & 1) ? EPI_BUF1 : EPI_BUF0);
        { const int row = wr * 16 + fr;
#pragma unroll
          for (int bj = 0; bj < 2; ++bj) { const int chunk = bj * 16 + wc * 4 + fq; *(PG8_LAS u32x4*)(buf + row * 512 + ((chunk ^ (row & 7)) * 16)) = piece(ai, m, bj); } }
        asm volatile("s_waitcnt lgkmcnt(0)" ::: "memory"); __builtin_amdgcn_s_barrier(); asm volatile("" ::: "memory");
#pragma unroll
        for (int i = 0; i < 2; ++i) { const int row = wid * 4 + i * 2 + (lane >> 5), chunk = lane & 31;
            const u32x4 v = *(const PG8_LAS u32x4*)(buf + row * 512 + ((chunk ^ (row & 7)) * 16));
            const int grow = ai * HALF + (row >> 4) * 64 + m * 16 + (row & 15);
            *(u32x4*)(tile + (size_t)grow * ld + chunk * 8) = v; }
    }
}
template <bool B> struct BoolC { static constexpr bool value = B; };
struct Epi1 {
    static constexpr bool PERM = true, AFTER_DRAIN = false, PAIRED = false;
    bf16_t* H; const float* b_gk; const float* b_gate; unsigned char* G8; bf16_t* HG; bf16_t* ZG; bf16_t* ZS; bf16_t* QS;
    static __device__ __forceinline__ u32x4 pack(const f32x4& v0, const f32x4& v1) { u32x4 w; w.x = cvt_pk_bf16(v0[0], v0[1]); w.y = cvt_pk_bf16(v0[2], v0[3]); w.z = cvt_pk_bf16(v1[0], v1[1]); w.w = cvt_pk_bf16(v1[2], v1[3]); return w; }
    __device__ __forceinline__ void operator()(const f32x4 (&acc)[2][2][4][2], const Unit& u, int wr, int wc, int fr, int fq, PG8_LAS unsigned char* lds, int wid, int lane) const {
        const int row0 = u.pm * BM + wr * 64 + fr, col0 = u.pn * BM + wc * 32 + 8 * fq;
        const int pn = u.pn;
        if (pn >= 12) {
            const float* bias = b_gate + (col0 - HC_GA);
            f32x4 bl[2][2];
#pragma unroll
            for (int bj = 0; bj < 2; ++bj)
#pragma unroll
                for (int n = 0; n < 2; ++n) bl[bj][n] = *(const f32x4*)(bias + bj * HALF + 4 * n) * (-LOG2E);
            auto run = [&](auto clampc) {
#pragma unroll
            for (int ai = 0; ai < 2; ++ai)
#pragma unroll
                for (int m = 0; m < 4; ++m) { unsigned gw[4];
#pragma unroll
                    for (int bj = 0; bj < 2; ++bj)
#pragma unroll
                        for (int n = 0; n < 2; ++n) { unsigned p = 0u;
#pragma unroll
                            for (int e = 0; e < 4; ++e) { const float t = __builtin_fmaf(acc[ai][bj][m][n][e], -LOG2E, bl[bj][n][e]);
                                float r = __builtin_amdgcn_rcpf(__builtin_fmaf(__builtin_amdgcn_exp2f(t), 1.f / 255.f, 1.f / 255.f));
                                if (decltype(clampc)::value) r = __builtin_fmaxf(r, 1.f);
                                p = __builtin_amdgcn_cvt_pk_u8_f32(r, e, p); }
                            gw[bj * 2 + n] = p; }
                    __builtin_nontemporal_store((u32x4){gw[0], gw[1], gw[2], gw[3]}, (u32x4*)(G8 + ((((size_t)(u.pm * 8 + (pn - 12)) * 8 + wid) * 8 + (ai * 4 + m)) * 64 + lane) * 16)); }
            };
            if (pn >= 16) run(BoolC<true>{}); else run(BoolC<false>{});
            return;
        }
        int mode = 0;
        if (pn == 0) mode = 1; else if (pn == 2) mode = 2; else if (pn == 5 || pn == 6 || pn == 10 || pn == 11) mode = 3; else if (pn == 7 || pn == 8) mode = 4;
        f32x4 bv[2][2];
        if (mode == 2) { const float* bias = b_gk + (col0 - HC_LG);
#pragma unroll
            for (int bj = 0; bj < 2; ++bj)
#pragma unroll
                for (int n = 0; n < 2; ++n) bv[bj][n] = *(const f32x4*)(bias + bj * HALF + 4 * n); }
        int goff[2] = {0, 0};
        if (pn < 5) {
#pragma unroll
            for (int bj = 0; bj < 2; ++bj) { const int c = wc * 32 + 8 * fq + bj * HALF;
                if (pn < 3) goff[bj] = (c >> 6) * (2048 * 320) + pn * 64 + (c & 63);
                else { const int cv = (pn - 3) * 256 + c; goff[bj] = (cv >> 7) * (2048 * 320) + 192 + (cv & 127); } }
        }
#pragma unroll
        for (int ai = 0; ai < 2; ++ai)
#pragma unroll
            for (int m = 0; m < 4; ++m) { const int mrow = row0 + ai * HALF + m * 16; bf16_t* rowp = H + (size_t)mrow * SH_N + (col0 - HC_KS);
                bf16_t* grow = HG + ((size_t)(mrow >> 11) * 4 * 2048 + (mrow & 2047)) * 320;
#pragma unroll
                for (int bj = 0; bj < 2; ++bj) { f32x4 v0 = acc[ai][bj][m][0], v1 = acc[ai][bj][m][1];
                    if (mode == 1) { v0 = v0 * 0.125f; v1 = v1 * 0.125f; }
                    else if (mode == 4) { v0 = v0 * (0.125f * LOG2E); v1 = v1 * (0.125f * LOG2E); }
                    else if (mode == 2) {
#pragma unroll
                        for (int e = 0; e < 4; ++e) { v0[e] = t_lg2(v0[e] + bv[bj][0][e]); v1[e] = t_lg2(v1[e] + bv[bj][1][e]); } }
                    else if (mode == 3) {
#pragma unroll
                        for (int e = 0; e < 4; ++e) { v0[e] = v0[e] * __builtin_amdgcn_rcpf(1.f + __builtin_amdgcn_exp2f(v0[e] * -LOG2E)); v1[e] = v1[e] * __builtin_amdgcn_rcpf(1.f + __builtin_amdgcn_exp2f(v1[e] * -LOG2E)); } }
                    if (pn < 5) __builtin_nontemporal_store(pack(v0, v1), (u32x4*)(grow + goff[bj]));
                    else if (pn == 5 || pn == 6) {
                        const int cz = (pn - 5) * 256 + wc * 32 + 8 * fq + bj * HALF, hd = cz >> 7, v = cz & 127, t = mrow & 2047;
                        const size_t idx16 = ((((((size_t)((mrow >> 11) * 4 + hd) * 32 + (t >> 6)) * 2 + ((t >> 5) & 1)) * 4 + (v >> 5)) * 4 + ((v >> 3) & 3)) * 32 + (t & 31));
                        __builtin_nontemporal_store(pack(v0, v1), (u32x4*)(ZG + idx16 * 8)); }
                    else if (pn == 7 || pn == 8) {
                        const int cq = (pn - 7) * 256 + wc * 32 + 8 * fq + bj * HALF, hd = cq >> 6, d0 = cq & 63, t = mrow & 2047;
                        const size_t idx16 = ((((((size_t)((mrow >> 11) * 8 + hd) * 64 + (t >> 5)) * 4 + (d0 >> 4)) * 2 + ((d0 >> 3) & 1)) * 32 + (t & 31)));
                        __builtin_nontemporal_store(pack(v0, v1), (u32x4*)(QS + idx16 * 8)); }
                    else if (pn >= 10) {
                        const int cz = (pn - 10) * 256 + wc * 32 + 8 * fq + bj * HALF, hd = cz >> 6, t = mrow & 2047;
                        const size_t idx16 = (((((size_t)((mrow >> 11) * 8 + hd) * 64 + (t >> 5)) * 8 + ((cz & 63) >> 3)) * 32 + (t & 31)));
                        __builtin_nontemporal_store(pack(v0, v1), (u32x4*)(ZS + idx16 * 8)); }
                    else __builtin_nontemporal_store(pack(v0, v1), (u32x4*)(rowp + bj * HALF)); } }
    }
};
struct Epi3 {
    static constexpr bool PERM = true, AFTER_DRAIN = false, PAIRED = true;
    bf16_t* Mm; const unsigned char* G8;
    __device__ __forceinline__ void operator()(f32x4 (&acc)[2][2][4][2], const Unit& u, int wr, int wc, int fr, int fq, PG8_LAS unsigned char* lds, int wid, int lane) const {
        const int row0 = u.pm * BM + wr * 64 + fr, col0 = u.pn * BM + wc * 32 + 8 * fq; const int which = u.pb & 1;
        typedef unsigned u32x2 __attribute__((ext_vector_type(2)));
        int ln = lane; asm volatile("" : "+v"(ln));
        const unsigned char* gbase = G8 + (((size_t)(u.pm * 8 + u.pn) * 8 + wid) * 8 * 64 + ln) * 16;
        const unsigned char* gbb = gbase + (size_t)4 * 8 * 8 * 64 * 16;
        if (!which) {
            u32x4 gb[8], ga[8];
#pragma unroll
            for (int i = 0; i < 8; ++i) { gb[i] = __builtin_nontemporal_load((const u32x4*)(gbb + i * 1024)); ga[i] = __builtin_nontemporal_load((const u32x4*)(gbase + i * 1024)); }
            asm volatile("" ::: "memory");
#pragma unroll
            for (int ai = 0; ai < 2; ++ai)
#pragma unroll
                for (int m = 0; m < 4; ++m) { const u32x4 b4 = gb[ai * 4 + m], a4 = ga[ai * 4 + m];
#pragma unroll
                    for (int bj = 0; bj < 2; ++bj) { const unsigned bx = bj ? b4.z : b4.x, by = bj ? b4.w : b4.y, ax = bj ? a4.z : a4.x, ay = bj ? a4.w : a4.y;
#pragma unroll
                        for (int e = 0; e < 4; ++e) { acc[ai][bj][m][0][e] *= (float)((ax >> (8 * e)) & 0xffu) * __builtin_amdgcn_rcpf((float)((bx >> (8 * e)) & 0xffu));
                                                      acc[ai][bj][m][1][e] *= (float)((ay >> (8 * e)) & 0xffu) * __builtin_amdgcn_rcpf((float)((by >> (8 * e)) & 0xffu)); } } }
        } else {
            u32x4 gb[8];
#pragma unroll
            for (int i = 0; i < 8; ++i) gb[i] = __builtin_nontemporal_load((const u32x4*)(gbb + i * 1024));
            asm volatile("" ::: "memory");
#pragma unroll
            for (int ai = 0; ai < 2; ++ai)
#pragma unroll
                for (int m = 0; m < 4; ++m) { const size_t r = (size_t)(row0 + ai * HALF + m * 16); bf16_t* rowp = Mm + r * 1024 + col0; const u32x4 b4 = gb[ai * 4 + m];
#pragma unroll
                    for (int bj = 0; bj < 2; ++bj) { const unsigned bx = bj ? b4.z : b4.x, by = bj ? b4.w : b4.y; f32x4 v0 = acc[ai][bj][m][0], v1 = acc[ai][bj][m][1];
#pragma unroll
                        for (int e = 0; e < 4; ++e) { v0[e] *= (float)((bx >> (8 * e)) & 0xffu) * (1.f / 255.f); v1[e] *= (float)((by >> (8 * e)) & 0xffu) * (1.f / 255.f); }
                        u32x4 w; w.x = cvt_pk_bf16(v0[0], v0[1]); w.y = cvt_pk_bf16(v0[2], v0[3]); w.z = cvt_pk_bf16(v1[0], v1[1]); w.w = cvt_pk_bf16(v1[2], v1[3]);
                        *(u32x4*)(rowp + bj * HALF) = w; } }
        }
    }
};
struct Epi4 {
    static constexpr bool PERM = true, AFTER_DRAIN = false, PAIRED = false;
    bf16_t* Y;
    __device__ __forceinline__ void operator()(const f32x4 (&acc)[2][2][4][2], const Unit& u, int wr, int wc, int fr, int fq, PG8_LAS unsigned char* lds, int wid, int lane) const {
        staged_rows_bf16(lds, Y + (size_t)u.pm * BM * 1024 + u.pn * BM, 1024, wr, wc, fr, fq, wid, lane, [&](int ai, int m, int bj) {
            const f32x4 v0 = acc[ai][bj][m][0], v1 = acc[ai][bj][m][1];
            u32x4 w; w.x = cvt_pk_bf16(v0[0], v0[1]); w.y = cvt_pk_bf16(v0[2], v0[3]); w.z = cvt_pk_bf16(v1[0], v1[1]); w.w = cvt_pk_bf16(v1[2], v1[3]); return w; });
    }
};

template <class Epi, class Sched, bool ALIGN_EPI = false, bool SP2 = false>
__device__ __forceinline__ void gemm_phase(PG8_LAS unsigned char* lds, const Gemm g, const Sched& S, const Epi& E) {
    const int tid = threadIdx.x, wid = __builtin_amdgcn_readfirstlane(tid >> 6), lane = tid & 63, wr = wid >> 2, wc = wid & 3, fr = lane & 15, fq = lane >> 4;
    const int K = g.K, nt = K / BK;
    unsigned voffA[2], voffB[2];
#pragma unroll
    for (int i = 0; i < 2; ++i) { int R, C; stage_rc(tid * 16 + i * 8192, R, C); const int Rb = Epi::PERM ? ((R & ~31) + perm32(R & 31)) : R;
        voffA[i] = (unsigned)(R * g.lda + C) * 2u; voffB[i] = (unsigned)(Rb * g.ldb + C) * 2u; }
    const size_t kstep = (size_t)(BK * 2);
    const size_t hstepA = (size_t)HALF * g.lda * 2, hstepB = (size_t)HALF * g.ldb * 2;
    const size_t tstepA = 2 * hstepA, tstepB = 2 * hstepB;
    const unsigned ldsw = (unsigned)wid * 1024u;
    const int aoff = lds_byte(wr * 64 + fr, fq * 8), boff = lds_byte(wc * 32 + fr, fq * 8);
#define PG8_SA(b, h) (((b) * 2 + (h)) * HTB)
#define PG8_SB(b, h) ((4 + (b) * 2 + (h)) * HTB)
#define PG8_STAGE(bufoff, gbase, voff) do { _Pragma("unroll") for (int _i = 0; _i < 2; ++_i) \
        __builtin_amdgcn_global_load_lds((const unsigned*)((const char*)(gbase) + (voff)[_i]), (PG8_LAS unsigned*)(lds + (bufoff) + ldsw + _i * 8192), 16, 0, 0); } while (0)
#define PG8_LDA(dst, b, h) do { _Pragma("unroll") for (int m = 0; m < 4; ++m) _Pragma("unroll") for (int k = 0; k < 2; ++k) dst[m][k] = *(const PG8_LAS bf16x8*)(lds + PG8_SA(b, h) + aoff + m * 2048 + k * 1024); } while (0)
#define PG8_LDB(dst, b, h) do { _Pragma("unroll") for (int n = 0; n < 2; ++n) _Pragma("unroll") for (int k = 0; k < 2; ++k) dst[n][k] = *(const PG8_LAS bf16x8*)(lds + PG8_SB(b, h) + boff + n * 2048 + k * 1024); } while (0)
#define PG8_MMA(ai, bj, At, Bt) do { __builtin_amdgcn_s_setprio(1); _Pragma("unroll") for (int m = 0; m < 4; ++m) _Pragma("unroll") for (int n = 0; n < 2; ++n) _Pragma("unroll") for (int k = 0; k < 2; ++k) \
        acc[ai][bj][m][n] = __builtin_amdgcn_mfma_f32_16x16x32_bf16(Bt[n][k], At[m][k], acc[ai][bj][m][n], 0, 0, 0); __builtin_amdgcn_s_setprio(0); } while (0)
#define PG8_WAIT_V(n) asm volatile("s_waitcnt vmcnt(" #n ")" ::: "memory")
#define PG8_WAIT_L(n) asm volatile("s_waitcnt lgkmcnt(" #n ")" ::: "memory")
#define PG8_BAR __builtin_amdgcn_s_barrier()
#define PG8_SCHED __builtin_amdgcn_sched_barrier(0)
    Unit cur, nxt; int ui = 0;
    if (!S.next(0, cur)) return;
    f32x4 acc[2][2][4][2];
#pragma unroll
    for (int a = 0; a < 2; ++a)
#pragma unroll
        for (int b = 0; b < 2; ++b)
#pragma unroll
            for (int m = 0; m < 4; ++m)
#pragma unroll
                for (int n = 0; n < 2; ++n) acc[a][b][m][n] = (f32x4){0.f, 0.f, 0.f, 0.f};
    bf16x8 At[4][2], B0[2][2], B1[2][2];
    const char* cA = (const char*)g.A + (size_t)cur.pm * tstepA + cur.acol; const char* cB = (const char*)g.Bt + (size_t)cur.pb * tstepB;
    S.a_ready(cur);
    if constexpr (SP2) {
        PG8_STAGE(PG8_SB(0, 0), cB, voffB); PG8_STAGE(PG8_SB(0, 1), cB + hstepB, voffB); PG8_STAGE(PG8_SA(0, 0), cA, voffA); PG8_STAGE(PG8_SA(0, 1), cA + hstepA, voffA);
        if (wr == 1) PG8_BAR;
        PG8_WAIT_V(2); PG8_BAR;
        PG8_STAGE(PG8_SB(1, 0), cB + kstep, voffB); PG8_STAGE(PG8_SA(1, 0), cA + kstep, voffA); PG8_STAGE(PG8_SB(1, 1), cB + hstepB + kstep, voffB);
        PG8_WAIT_V(6); PG8_BAR;
    } else {
        PG8_STAGE(PG8_SB(0, 0), cB, voffB); PG8_STAGE(PG8_SA(0, 0), cA, voffA); PG8_STAGE(PG8_SB(0, 1), cB + hstepB, voffB); PG8_STAGE(PG8_SA(0, 1), cA + hstepA, voffA);
        if (wr == 1) PG8_BAR;
        PG8_WAIT_V(4); PG8_BAR;
        PG8_STAGE(PG8_SB(1, 0), cB + kstep, voffB); PG8_STAGE(PG8_SA(1, 0), cA + kstep, voffA); PG8_STAGE(PG8_SB(1, 1), cB + hstepB + kstep, voffB);
        PG8_WAIT_V(6); PG8_BAR;
    }
    for (;;) {
        const bool has_next = S.next(ui + 1, nxt);
        const char* nA = has_next ? (const char*)g.A + (size_t)nxt.pm * tstepA + nxt.acol : cA; const char* nB = has_next ? (const char*)g.Bt + (size_t)nxt.pb * tstepB : cB;
        for (int t = 0; t < nt; t += 2) {
            const bool last = (t == nt - 2);
            const char* a1 = cA + (size_t)(t + 1) * kstep;
            const char* a2 = last ? nA : cA + (size_t)(t + 2) * kstep; const char* b2 = last ? nB : cB + (size_t)(t + 2) * kstep;
            const char* a3 = a2 + kstep; const char* b3 = b2 + kstep;
            if (last && has_next) S.a_ready(nxt);
            if constexpr (SP2) {
            PG8_LDB(B0, 0, 0); PG8_LDB(B1, 0, 1); PG8_SCHED; PG8_LDA(At, 0, 0); PG8_STAGE(PG8_SA(1, 1), a1 + hstepA, voffA);
            PG8_WAIT_V(8); PG8_WAIT_L(0); PG8_BAR; PG8_MMA(0, 0, At, B0); PG8_MMA(0, 1, At, B1); PG8_BAR; PG8_SCHED;
            PG8_LDA(At, 0, 1); PG8_STAGE(PG8_SB(0, 0), b2, voffB); PG8_STAGE(PG8_SB(0, 1), b2 + hstepB, voffB); PG8_STAGE(PG8_SA(0, 0), a2, voffA);
            PG8_WAIT_V(8); PG8_WAIT_L(0); PG8_BAR; PG8_MMA(1, 0, At, B0); PG8_MMA(1, 1, At, B1); PG8_BAR; PG8_SCHED;
            PG8_LDB(B0, 1, 0); PG8_LDB(B1, 1, 1); PG8_SCHED; PG8_LDA(At, 1, 0); PG8_STAGE(PG8_SA(0, 1), a2 + hstepA, voffA);
            PG8_WAIT_V(8); PG8_WAIT_L(0); PG8_BAR; PG8_MMA(0, 0, At, B0); PG8_MMA(0, 1, At, B1); PG8_BAR; PG8_SCHED;
            PG8_LDA(At, 1, 1); PG8_STAGE(PG8_SB(1, 0), b3, voffB); PG8_STAGE(PG8_SB(1, 1), b3 + hstepB, voffB); PG8_STAGE(PG8_SA(1, 0), a3, voffA);
            PG8_WAIT_V(8); PG8_WAIT_L(0); PG8_BAR; PG8_MMA(1, 0, At, B0); PG8_MMA(1, 1, At, B1); PG8_BAR; PG8_SCHED;
            } else {
            PG8_LDB(B0, 0, 0); PG8_SCHED; PG8_LDA(At, 0, 0); PG8_STAGE(PG8_SA(1, 1), a1 + hstepA, voffA);
            PG8_WAIT_L(8); PG8_BAR; PG8_WAIT_L(0); PG8_MMA(0, 0, At, B0); PG8_BAR; PG8_SCHED;
            PG8_LDB(B1, 0, 1); PG8_STAGE(PG8_SB(0, 0), b2, voffB);
            PG8_BAR; PG8_WAIT_L(0); PG8_MMA(0, 1, At, B1); PG8_BAR;
            PG8_LDA(At, 0, 1); PG8_STAGE(PG8_SA(0, 0), a2, voffA);
            PG8_BAR; PG8_WAIT_L(0); PG8_MMA(1, 0, At, B0); PG8_BAR; PG8_SCHED;
            PG8_STAGE(PG8_SB(0, 1), b2 + hstepB, voffB);
            PG8_WAIT_V(6); PG8_BAR; PG8_MMA(1, 1, At, B1); PG8_BAR;
            PG8_LDB(B0, 1, 0); PG8_SCHED; PG8_LDA(At, 1, 0); PG8_STAGE(PG8_SA(0, 1), a2 + hstepA, voffA);
            PG8_WAIT_L(8); PG8_BAR; PG8_WAIT_L(0); PG8_MMA(0, 0, At, B0); PG8_BAR; PG8_SCHED;
            PG8_LDB(B1, 1, 1); PG8_STAGE(PG8_SB(1, 0), b3, voffB);
            PG8_BAR; PG8_WAIT_L(0); PG8_MMA(0, 1, At, B1); PG8_BAR;
            PG8_LDA(At, 1, 1); PG8_STAGE(PG8_SA(1, 0), a3, voffA);
            PG8_BAR; PG8_WAIT_L(0); PG8_MMA(1, 0, At, B0); PG8_BAR; PG8_SCHED;
            PG8_STAGE(PG8_SB(1, 1), b3 + hstepB, voffB);
            PG8_WAIT_V(6); PG8_BAR; PG8_MMA(1, 1, At, B1); PG8_BAR;
            }
        }
        if constexpr (ALIGN_EPI) { if (wr == 0) PG8_BAR; }
        if constexpr (!Epi::AFTER_DRAIN) { E(acc, cur, wr, wc, fr, fq, lds, wid, lane); S.done(cur); }
        if (!has_next) break;
        if (!Epi::PAIRED || (cur.pb & 1)) {
#pragma unroll
        for (int a = 0; a < 2; ++a)
#pragma unroll
            for (int b = 0; b < 2; ++b)
#pragma unroll
                for (int m = 0; m < 4; ++m)
#pragma unroll
                    for (int n = 0; n < 2; ++n) acc[a][b][m][n] = (f32x4){0.f, 0.f, 0.f, 0.f};
        }
        cur = nxt; cA = nA; cB = nB; ++ui;
        if constexpr (ALIGN_EPI) { if (wr == 1) PG8_BAR; }
    }
    PG8_WAIT_V(0);
    if constexpr (!ALIGN_EPI) { if (wr == 0) PG8_BAR; }
    PG8_BAR;
    if constexpr (Epi::AFTER_DRAIN) { E.fused(acc, cur, wr, wc, fr, fq, lds, wid, lane); S.done(cur); }
#undef PG8_SA
#undef PG8_SB
#undef PG8_STAGE
#undef PG8_LDA
#undef PG8_LDB
#undef PG8_MMA
#undef PG8_WAIT_V
#undef PG8_WAIT_L
#undef PG8_BAR
#undef PG8_SCHED
}
}

constexpr int NWAVES = 8;
#ifndef MK_N_LAUNCHES
#define MK_N_LAUNCHES 1
#endif
constexpr int N_LAUNCHES = MK_N_LAUNCHES;
constexpr int PER_PHASE = 6;

constexpr int BATCH = 32, SEQ = 2048, D = 1024, M = BATCH * SEQ;
constexpr int D_IN = 4880, HN = pg8::HN;
constexpr float LN_EPS = 1e-5f, RMS_EPS = 1e-6f, ALPHA = 1.189207115002721f;
using pg8::HC_QG; using pg8::HC_KG; using pg8::HC_LG; using pg8::HC_VG; using pg8::HC_ZG; using pg8::HC_QS; using pg8::HC_KS; using pg8::HC_VS; using pg8::HC_ZS; using pg8::HC_GA; using pg8::HC_GB;
using pg8::LOG2E;

constexpr size_t MiB = 1u << 20;
constexpr size_t WS_CTL = 0, CTL_ZERO_BYTES = 1 * MiB;
constexpr size_t WS_WIN = 2 * MiB;
constexpr size_t WS_WO12 = 12 * MiB;
constexpr size_t WS_WOUT = 14 * MiB;
constexpr size_t WS_XB = 16 * MiB;
constexpr size_t WS_MM = 464 * MiB;
constexpr size_t WS_A12 = 144 * MiB;
constexpr size_t WS_H = 272 * MiB;
constexpr size_t WS_QS = 304 * MiB;
constexpr size_t WS_ZS = 400 * MiB;
constexpr size_t WS_G8 = 656 * MiB;
constexpr size_t WS_HG = 784 * MiB;
constexpr size_t WS_ZG = 944 * MiB;
constexpr size_t WS_END = 1008 * MiB;
constexpr int CW_TMO = 0, CW_CODE = 1;
constexpr int CW_SWAQ = 2048;
constexpr int CW_BAR = 4096;

constexpr int RING_OFF = 0, RING_BYTES = 131072;
constexpr int LDSCTL_OFF = RING_BYTES, MISC_OFF = LDSCTL_OFF + 320;
constexpr int LDS_BYTES = 163840;
static_assert(MISC_OFF + 128 <= RING_BYTES + 1024 && RING_BYTES + 1024 + 16384 <= LDS_BYTES, "LDS map");

#define GAS __attribute__((address_space(1)))
#define LAS __attribute__((address_space(3)))
typedef unsigned short bf16;
typedef unsigned v4u __attribute__((ext_vector_type(4)));
typedef unsigned v2u __attribute__((ext_vector_type(2)));
typedef float f32x4 __attribute__((ext_vector_type(4)));
typedef GAS unsigned gu32;
typedef GAS unsigned long long gu64;
#define RLX_AGENT __ATOMIC_RELAXED, __HIP_MEMORY_SCOPE_AGENT
#define LDS_WAIT() asm volatile("s_waitcnt lgkmcnt(0)" ::: "memory")
#define VM_WAIT() asm volatile("s_waitcnt vmcnt(0)" ::: "memory")
__device__ __forceinline__ unsigned f2bf(float f) { unsigned u = __builtin_bit_cast(unsigned, f); return (u + 0x7fffu + ((u >> 16) & 1u)) >> 16; }
__device__ __forceinline__ unsigned pk2(float lo, float hi) { return pg8::cvt_pk_bf16(lo, hi); }
__device__ __forceinline__ float bflo(unsigned w) { return __uint_as_float(w << 16); }
__device__ __forceinline__ float bfhi(unsigned w) { return __uint_as_float(w & 0xffff0000u); }
__device__ __forceinline__ float bf1(bf16 h) { return __uint_as_float(((unsigned)h) << 16); }

#define XB_TMO      128
#define XB_XCNT(j)  (256  + 64 * (j))
#define XB_XSUB(j)  (1280 + 64 * (j))
#define XB_XGEN(j)  (2304 + 64 * (j))
#define XB_TOP      3328
#define XB_TOPGEN   3392
#define XCD_BAR_WORDS 3456
#define XB_SPIN_CAP (1u << 18)

__device__ __forceinline__ unsigned xb_ld(unsigned* p)              { return __hip_atomic_load(p, __ATOMIC_RELAXED, __HIP_MEMORY_SCOPE_AGENT); }
__device__ __forceinline__ unsigned xb_add(unsigned* p, unsigned v) { return __hip_atomic_fetch_add(p, v, __ATOMIC_RELAXED, __HIP_MEMORY_SCOPE_AGENT); }
__device__ __forceinline__ unsigned xb_xcc_id() { return (unsigned)__builtin_amdgcn_s_getreg((3 << 11) | 20) & 0xFu; }
#define XB_SPIN(cond, bar) do { unsigned _sp = 0; while (cond) { __builtin_amdgcn_s_sleep(1); \
    if ((++_sp & 255u) == 0u) { if (xb_ld(&(bar)[XB_TMO])) break; if (_sp > XB_SPIN_CAP) { atomicAdd(&(bar)[XB_TMO], 1u); break; } } } } while (0)

struct XcdBarrier {
    unsigned* bar; unsigned x;
    volatile LAS unsigned* st;
};

__device__ __forceinline__ XcdBarrier xcd_barrier_post(unsigned* bar, volatile LAS unsigned* st) {
    XcdBarrier b; b.bar = bar; b.x = xb_xcc_id(); b.st = st;
    if (threadIdx.x == 0) (void)xb_add(&bar[XB_XCNT(b.x)], 1u);
    return b;
}
__device__ __forceinline__ void xcd_barrier_complete(unsigned* bar, unsigned x, unsigned& nloc, unsigned& nx) {
    const unsigned G = gridDim.x * gridDim.y * gridDim.z;
    unsigned sum, cnt, mine, sp = 0u;
    for (;;) {
        sum = 0u; cnt = 0u; mine = 0u;
#pragma unroll
        for (unsigned j = 0; j < 16; ++j) { const unsigned c = xb_ld(&bar[XB_XCNT(j)]); sum += c; cnt += (c > 0u) ? 1u : 0u; mine = (j == x) ? c : mine; }
        if (sum == G) break;
        __builtin_amdgcn_s_sleep(1);
        if ((++sp & 255u) == 0u) { if (xb_ld(&bar[XB_TMO])) break; if (sp > XB_SPIN_CAP) { atomicAdd(&bar[XB_TMO], 1u); break; } }
    }
    nloc = mine > 0u ? mine : 1u; nx = cnt > 0u ? cnt : 1u;
}

__device__ __forceinline__ void xcd_barrier(const XcdBarrier& b) {
    asm volatile("s_waitcnt vmcnt(0)" ::: "memory");
    __syncthreads();
    if (threadIdx.x == 0) {
        unsigned* bar = b.bar;
        __builtin_amdgcn_s_waitcnt(0);
        unsigned nloc = b.st[0], nx = b.st[1];
        if (nloc == 0u) { xcd_barrier_complete(bar, b.x, nloc, nx); b.st[0] = nloc; b.st[1] = nx; }
        const unsigned old = xb_add(&bar[XB_XSUB(b.x)], 1u);
        const unsigned gen = old / nloc;
        if (old + 1u == (gen + 1u) * nloc) {
            __builtin_amdgcn_fence(__ATOMIC_RELEASE, "agent");
            asm volatile("s_waitcnt vmcnt(0)" ::: "memory");
            const unsigned og = xb_add(&bar[XB_TOP], 1u);
            const unsigned tg = og / nx;
            if (og + 1u == (tg + 1u) * nx) xb_add(&bar[XB_TOPGEN], 1u);
            else XB_SPIN(xb_ld(&bar[XB_TOPGEN]) == tg, bar);
            __builtin_amdgcn_fence(__ATOMIC_ACQUIRE, "agent");
            xb_add(&bar[XB_XGEN(b.x)], 1u);
            asm volatile("s_waitcnt vmcnt(0)" ::: "memory");
        } else {
            XB_SPIN(xb_ld(&bar[XB_XGEN(b.x)]) == gen, bar);
            __builtin_amdgcn_fence(__ATOMIC_ACQUIRE, "agent");
            asm volatile("s_waitcnt vmcnt(0)" ::: "memory");
        }
    }
    __syncthreads();
}

struct Frame {
    LAS unsigned char* lds;
    volatile LAS unsigned* MISC;
    gu32* ctl;
    int tid, lane, wave;
    int vcu, G;
    const float *x, *w_in, *w_gk2, *b_gk, *gla_norm_g, *w_o_gla, *sinks, *w_o_swa, *b_gate, *w_out, *ln_g, *ln_b; float* out;
    bf16 *Win_t, *Wo12_t, *Wout_t, *XB, *A12, *H, *Mm, *Yb, *HG, *ZG, *ZS, *QS; unsigned char* G8;
};
__device__ __forceinline__ float wave_sum(float v) {
#pragma unroll
    for (int o = 1; o < 64; o <<= 1) v += __shfl_xor(v, o);
    return v;
}
__device__ __forceinline__ void tr_item(const float* W, int ldw, int s0, int k0, bf16* WT, int ldt, int drow0, LAS float* scr, int lane) {
#pragma unroll 8
    for (int i = 0; i < 32; ++i) { const int kk = 2 * i + (lane >> 5); scr[kk * 33 + (lane & 31)] = W[(size_t)(k0 + kk) * ldw + s0 + (lane & 31)]; }
    LDS_WAIT(); asm volatile("" ::: "memory");
    const int c = lane & 7;
#pragma unroll
    for (int j = 0; j < 4; ++j) { const int n = (lane >> 3) + 8 * j; const LAS float* s = scr + (8 * c) * 33 + n;
        v4u o; o.x = pk2(s[0 * 33], s[1 * 33]); o.y = pk2(s[2 * 33], s[3 * 33]); o.z = pk2(s[4 * 33], s[5 * 33]); o.w = pk2(s[6 * 33], s[7 * 33]);
        *(GAS v4u*)(WT + (size_t)(drow0 + n) * ldt + k0 + 8 * c) = o; }
    LDS_WAIT(); asm volatile("" ::: "memory");
}
__device__ __forceinline__ int win_src_col(int n) {
    if (n < 512) return n;
    if (n < 1280) return n - 768 + 512;
    if (n < 1792) return n - 1280 + 1040;
    if (n < 2304) return n - 1792 + 1552;
    if (n < 2432) return n - 2304 + 2064;
    if (n < 2560) return n - 2432 + 2192;
    if (n < 3072) return n - 2560 + 2320;
    return n - 3072 + 2832;
}
__device__ __forceinline__ void p0_prologue(Frame& F) {
    LAS float* scr = (LAS float*)(F.lds + RING_OFF + F.wave * 16384);
    const int gw = F.vcu * NWAVES + F.wave, NGW = F.G * NWAVES;
    constexpr int I_IN = 16 * 152, I_OG = 8 * 32, I_OS = 8 * 32, I_OUT = 16 * 32;
    constexpr int NITEMS = I_IN + I_OG + I_OS + I_OUT;
    for (int it = gw; it < NITEMS; it += NGW) {
        int r = it;
        if (r < I_IN) { const int kb = r / 152; int nb = r % 152; if (nb >= 16) nb += 8;
            tr_item(F.w_in, D_IN, win_src_col(32 * nb), 64 * kb, F.Win_t, D, 32 * nb, scr, F.lane); continue; }
        r -= I_IN;
        if (r < I_OG) { const int kb = r >> 5, nb = r & 31; tr_item(F.w_o_gla, D, 32 * nb, 64 * kb, F.Wo12_t, 512, (2 * (nb >> 3)) * 256 + 32 * (nb & 7), scr, F.lane); continue; }
        r -= I_OG;
        if (r < I_OS) { const int kb = r >> 5, nb = r & 31; tr_item(F.w_o_swa, D, 32 * nb, 64 * kb, F.Wo12_t, 512, (2 * (nb >> 3) + 1) * 256 + 32 * (nb & 7), scr, F.lane); continue; }
        r -= I_OS;
        { const int kb = r >> 5, nb = r & 31; tr_item(F.w_out, D, 32 * nb, 64 * kb, F.Wout_t, D, 32 * nb, scr, F.lane); }
    }
}
typedef short bf16x8 __attribute__((ext_vector_type(8)));
typedef short s16x4 __attribute__((ext_vector_type(4)));
typedef float f32x16 __attribute__((ext_vector_type(16)));
__device__ __forceinline__ s16x4 vtr(const LAS char* p) { return __builtin_bit_cast(s16x4, __builtin_amdgcn_ds_read_tr16_b64_v4i16((LAS s16x4*)p)); }
__device__ __forceinline__ bf16x8 pack8(const f32x16& x, int s) {
    v4u p; p.x = pk2(x[8 * s], x[8 * s + 1]); p.y = pk2(x[8 * s + 2], x[8 * s + 3]); p.z = pk2(x[8 * s + 4], x[8 * s + 5]); p.w = pk2(x[8 * s + 6], x[8 * s + 7]);
    return __builtin_bit_cast(bf16x8, p);
}
__device__ __forceinline__ f32x16 zero16() { f32x16 z;
#pragma unroll
    for (int e = 0; e < 16; ++e) z[e] = 0.f;
    return z; }
#define MFMA32(a, b, c) __builtin_amdgcn_mfma_f32_32x32x16_bf16((a), (b), (c), 0, 0, 0)
constexpr int SWS = 144, SWA_KOFF = 0, SWA_VOFF = 256 * SWS, SWA_QW = 2 * 256 * SWS, SWA_OST = SWA_QW + 256, SWA_NITEMS = BATCH * 2 * (SEQ / 128);
static_assert(SWA_OST + 8 * 4096 <= RING_BYTES, "SWA LDS map");
__device__ __forceinline__ void swa_stage_load(Frame& F, int item, v4u (&kr)[4], v4u (&vr)[4]) {
    const int n = item & 15, kvh = (item >> 4) & 1, b = item >> 5;
#pragma unroll
    for (int i = 0; i < 4; ++i) { const int p = F.tid + 512 * i, row = p >> 3, pc = p & 7; int key = 128 * (n - 1) + row; key = key < 0 ? 0 : key;
        const bf16* src = F.H + (size_t)(b * SEQ + key) * pg8::SH_N + kvh * 64 + pc * 8;
        kr[i] = *(const v4u*)(src + pg8::SH_KS); vr[i] = *(const v4u*)(src + pg8::SH_VS); }
}
__device__ __forceinline__ void swa_stage_write(Frame& F, LAS char* L, const v4u (&kr)[4], const v4u (&vr)[4]) {
#pragma unroll
    for (int i = 0; i < 4; ++i) { const int p = F.tid + 512 * i, row = p >> 3, pc = p & 7;
        *(LAS v4u*)(L + SWA_KOFF + row * SWS + pc * 16) = kr[i]; *(LAS v4u*)(L + SWA_VOFF + row * SWS + pc * 16) = vr[i]; }
}
__device__ __forceinline__ void swa_compute(Frame& F, int lane, int item, const LAS char* L) {
    const int n = item & 15, kvh = (item >> 4) & 1, b = item >> 5;
    const int r32 = lane & 31, hh = lane >> 5, sb = F.wave & 3;
    const int qb32 = 4 * n + sb, t0 = qb32 * 32;
    const bf16* Hb = F.H + (size_t)b * SEQ * pg8::SH_N;
    const int trq = (lane & 15) >> 2, trp = lane & 3, trg = (lane >> 4) & 1;
    const LAS char* vrd = L + SWA_VOFF + (4 * hh + trq) * SWS + (16 * trg + 4 * trp) * 2;
    const LAS char* krd = L + SWA_KOFF + r32 * SWS + 16 * hh;
    const int ibase = r32 - 4 * hh; const float fbase = (float)ibase;
#pragma unroll 1
    for (int gi = 0; gi < 2; ++gi) {
        const int h = kvh * 4 + 2 * (F.wave >> 2) + gi;
        const float slope2 = __builtin_amdgcn_exp2f(-(float)(h + 1)) * LOG2E, sink2 = F.sinks[h] * LOG2E;
        const float nslope2 = -slope2;
        bf16x8 qf[4];
        { const bf16* qp = F.QS + (((size_t)(b * 8 + h) * 64 + qb32) * 4 * 2 * 32 + lane) * 8;
#pragma unroll
          for (int ds = 0; ds < 4; ++ds) qf[ds] = *(const bf16x8*)(qp + (size_t)ds * 2 * 32 * 8); }
        const size_t row = (size_t)b * SEQ + t0 + r32;
        v2u zq[8];
        { const bf16* zp = F.ZS + ((((size_t)(b * 8 + h) * 64 + qb32) * 8) * 32 + r32) * 8 + 4 * hh;
#pragma unroll
          for (int i = 0; i < 8; ++i) zq[i] = *(const v2u*)(zp + (size_t)i * 32 * 8); }
        f32x16 sc[5]; float mx = sink2;
#pragma unroll
        for (int r = 0; r < 5; ++r) {
            const int c = qb32 - 4 + r;
            if (c >= 0) {
                f32x16 acc = zero16();
#pragma unroll
                for (int ds = 0; ds < 4; ++ds) { const bf16x8 kf = *(const LAS bf16x8*)(krd + (32 * (sb + r)) * SWS + 32 * ds); acc = MFMA32(kf, qf[ds], acc); }
                float a0 = nslope2 * (fbase + (float)(128 - 32 * r)); asm volatile("" : "+v"(a0));
#pragma unroll
                for (int e = 0; e < 16; ++e) {
                    const int ce = (e & 3) + 8 * (e >> 2);
                    float s = __builtin_fmaf(slope2, (float)ce, acc[e] + a0);
                    if (r == 0) s = (ibase < ce) ? s : -INFINITY;
                    if (r == 4) s = (ibase >= ce) ? s : -INFINITY;
                    sc[r][e] = s; mx = __builtin_fmaxf(mx, s); }
            } else {
#pragma unroll
                for (int e = 0; e < 16; ++e) sc[r][e] = -INFINITY;
            }
        }
        mx = __builtin_fmaxf(mx, __shfl_xor(mx, 32));
        float l = 0.f;
        bf16x8 pbs[5][2];
#pragma unroll
        for (int r = 0; r < 5; ++r) {
#pragma unroll
            for (int e = 0; e < 16; ++e) { const float p = __builtin_amdgcn_exp2f(sc[r][e] - mx); sc[r][e] = p; l += p; }
            pbs[r][0] = pack8(sc[r], 0); pbs[r][1] = pack8(sc[r], 1); }
        l += __shfl_xor(l, 32); l += __builtin_amdgcn_exp2f(sink2 - mx);
        f32x16 o[2]; o[0] = zero16(); o[1] = zero16();
#pragma unroll
        for (int r = 0; r < 5; ++r) {
            const int c = qb32 - 4 + r;
            if (c >= 0) {
#pragma unroll
                for (int s = 0; s < 2; ++s) { const bf16x8 pb = pbs[r][s];
#pragma unroll
                    for (int db = 0; db < 2; ++db) {
                        const s16x4 lo = vtr(vrd + (32 * (sb + r) + 16 * s) * SWS + db * 64), hi = vtr(vrd + (32 * (sb + r) + 16 * s + 8) * SWS + db * 64);
                        const bf16x8 vf = __builtin_shufflevector(lo, hi, 0, 1, 2, 3, 4, 5, 6, 7);
                        o[db] = MFMA32(vf, pb, o[db]); } }
            }
        }
        const float il = 1.f / l; LAS char* ost = (LAS char*)L + SWA_OST + F.wave * 4096;
#pragma unroll
        for (int db = 0; db < 2; ++db)
#pragma unroll
            for (int q4 = 0; q4 < 4; ++q4) { const int d = 32 * db + 8 * q4 + 4 * hh; const v2u z = zq[4 * db + q4]; v2u w;
                w.x = pk2(o[db][4 * q4] * il * bflo(z.x), o[db][4 * q4 + 1] * il * bfhi(z.x)); w.y = pk2(o[db][4 * q4 + 2] * il * bflo(z.y), o[db][4 * q4 + 3] * il * bfhi(z.y));
                *(LAS v2u*)(ost + r32 * 128 + ((2 * d) ^ ((r32 & 7) << 4))) = w; }
        bf16* op = F.A12 + ((size_t)b * SEQ + t0) * 1024 + 512 + h * 64;
#pragma unroll
        for (int i = 0; i < 4; ++i) { const int rr = 8 * i + (lane >> 3), ch = lane & 7;
            const v4u v = *(const LAS v4u*)(ost + rr * 128 + ((ch ^ (rr & 7)) << 4));
            *(v4u*)(op + (size_t)rr * 1024 + ch * 8) = v; }
    }
}
__device__ __forceinline__ void swa_mfma(Frame& F) {
    LAS char* L = (LAS char*)(F.lds + RING_OFF);
    volatile LAS int* qw = (volatile LAS int*)(L + SWA_QW);
    int lane = F.lane; asm volatile("" : "+v"(lane));
    if (F.tid == 0) { qw[0] = (int)__hip_atomic_fetch_add((unsigned*)(F.ctl + CW_SWAQ), 1u, __ATOMIC_RELAXED, __HIP_MEMORY_SCOPE_AGENT);
                      qw[1] = (int)__hip_atomic_fetch_add((unsigned*)(F.ctl + CW_SWAQ), 1u, __ATOMIC_RELAXED, __HIP_MEMORY_SCOPE_AGENT); }
    __syncthreads();
    int item = qw[0], next = qw[1];
    v4u kr[4], vr[4];
    if (item < SWA_NITEMS) swa_stage_load(F, item, kr, vr);
    while (item < SWA_NITEMS) {
        swa_stage_write(F, L, kr, vr);
        int nn = 0;
        if (F.tid == 0) nn = (int)__hip_atomic_fetch_add((unsigned*)(F.ctl + CW_SWAQ), 1u, __ATOMIC_RELAXED, __HIP_MEMORY_SCOPE_AGENT);
        __syncthreads();
        if (next < SWA_NITEMS) swa_stage_load(F, next, kr, vr);
        int ln = lane; asm volatile("" : "+v"(ln));
        swa_compute(F, ln, item, L);
        if (F.tid == 0) qw[2] = nn;
        __syncthreads();
        item = next; next = qw[2];
    }
}
constexpr int GQS = 136, GVS = 264, GLA_QOFF = 0, GLA_KOFF = 64 * GQS, GLA_GOFF = 2 * 64 * GQS, GLA_VOFF = 3 * 64 * GQS, GLA_BUF = 3 * 64 * GQS + 64 * GVS;
constexpr int GLA_SS = 2 * GLA_BUF, GLA_SCR = GLA_SS + 2 * 64 * 4 * 4;
static_assert(GLA_SCR + 8 * 256 <= RING_BYTES, "GLA LDS map");
__device__ __forceinline__ bf16x8 trfrag(const LAS char* p, int rs8) { const s16x4 lo = vtr(p), hi = vtr(p + rs8); return __builtin_shufflevector(lo, hi, 0, 1, 2, 3, 4, 5, 6, 7); }
__device__ __forceinline__ float bfel(const bf16x8& f, int j) { return __uint_as_float(((unsigned)(unsigned short)f[j]) << 16); }
__device__ __forceinline__ void gla_stage_load(const bf16* chunk, int tid, v4u (&st)[5]) {
#pragma unroll
    for (int i = 0; i < 5; ++i) st[i] = *(const v4u*)(chunk + (size_t)(tid + 512 * i) * 8);
}
__device__ __forceinline__ void gla_stage_write(LAS char* buf, int tid, const v4u (&st)[5]) {
#pragma unroll
    for (int i = 0; i < 5; ++i) { const int p = tid + 512 * i, row = p / 40, pp = p - row * 40;
        LAS char* dst = (pp < 24) ? buf + (pp >> 3) * 64 * GQS + row * GQS + (pp & 7) * 16 : buf + GLA_VOFF + row * GVS + (pp - 24) * 16;
        *(LAS v2u*)dst = (v2u){st[i].x, st[i].y}; *(LAS v2u*)(dst + 8) = (v2u){st[i].z, st[i].w}; }
}
constexpr int G2_QDF = 2 * GLA_BUF, G2_KIF = G2_QDF + 8192, G2_KTE = G2_KIF + 8192, G2_SF0 = G2_KTE + 8192;
constexpr int G2_HI = RING_BYTES + 1024, G2_SF1 = G2_HI, G2_ATF = G2_SF1 + 16384, G2_DEC = G2_ATF + 6144, G2_SS = G2_DEC + 256;
static_assert(G2_SF0 + 16384 <= RING_BYTES && G2_SS + 2048 <= LDS_BYTES, "GLA v2 LDS map");
__device__ __forceinline__ void fput(LAS char* base, int idx, int lane, const bf16x8& f) { *(LAS bf16x8*)(base + idx * 1024 + lane * 16) = f; }
__device__ __forceinline__ bf16x8 fget(const LAS char* base, int idx, int lane) { return *(const LAS bf16x8*)(base + idx * 1024 + lane * 16); }
#define G2_SYNC() do { asm volatile("s_waitcnt lgkmcnt(0)" ::: "memory"); __builtin_amdgcn_s_barrier(); asm volatile("" ::: "memory"); } while (0)
__device__ __forceinline__ void gla_mfma2(Frame& F, int n_wg) {
    if ((int)blockIdx.x >= n_wg) return;
    const int tid = F.tid, lane = F.lane, r32 = lane & 31, hh = lane >> 5, w = F.wave, x = w >> 2, vb = w & 3;
    const int trq = (lane & 15) >> 2, trp = lane & 3, trg = (lane >> 4) & 1;
    const int tr_qk = (4 * hh + trq) * GQS + (16 * trg + 4 * trp) * 2, tr_v = (4 * hh + trq) * GVS + (16 * trg + 4 * trp) * 2;
    LAS char* L = (LAS char*)(F.lds + RING_OFF);
    LAS float* SS = (LAS float*)(L + G2_SS); LAS float* DEC = (LAS float*)(L + G2_DEC);
    bf16x8 Ua, Ub, ones;
#pragma unroll
    for (int j = 0; j < 8; ++j) { const int s0 = 8 * (j >> 2) + 4 * hh + (j & 3); Ua[j] = (s0 <= r32) ? (short)0x3F80 : (short)0; Ub[j] = (16 + s0 <= r32) ? (short)0x3F80 : (short)0; ones[j] = (short)0x3F80; }
    f32x4 gq[4];
#pragma unroll
    for (int q4 = 0; q4 < 4; ++q4) gq[q4] = *(const f32x4*)(F.gla_norm_g + 32 * vb + 8 * q4 + 4 * hh);
    for (int bh = blockIdx.x; bh < BATCH * 4; bh += n_wg) {
        const int b = bh >> 2, h = bh & 3;
        const bf16* Gb = F.HG + (size_t)bh * SEQ * 320;
        __syncthreads();
        { v4u st[5]; gla_stage_load(Gb, tid, st); gla_stage_write(L, tid, st); }
        { bf16x8 z8;
#pragma unroll
          for (int j = 0; j < 8; ++j) z8[j] = 0;
          fput(L + G2_SF0, (x * 4 + vb) * 2 + 0, lane, z8); fput(L + G2_SF0, (x * 4 + vb) * 2 + 1, lane, z8); }
        __syncthreads();
        f32x16 S = zero16();
        for (int c = 0; c < SEQ / 64; ++c) {
            const LAS char* B = L + (c & 1) * GLA_BUF;
            const size_t trow = (size_t)b * SEQ + c * 64 + 32 * x + r32;
            const bool more = (c + 1 < SEQ / 64);
            if (w < 4) {
                const int dl = w >> 1, tau = w & 1;
                f32x16 GT = zero16();
                { const bf16x8 g0 = trfrag(B + GLA_GOFF + tr_qk + dl * 64, 8 * GQS), g1 = trfrag(B + GLA_GOFF + tr_qk + 16 * GQS + dl * 64, 8 * GQS);
                  if (tau == 0) { GT = MFMA32(g0, Ua, GT); GT = MFMA32(g1, Ub, GT); }
                  else { const bf16x8 g2 = trfrag(B + GLA_GOFF + tr_qk + 32 * GQS + dl * 64, 8 * GQS), g3 = trfrag(B + GLA_GOFF + tr_qk + 48 * GQS + dl * 64, 8 * GQS);
                         GT = MFMA32(g0, ones, GT); GT = MFMA32(g1, ones, GT); GT = MFMA32(g2, Ua, GT); GT = MFMA32(g3, Ub, GT); } }
                f32x16 qd, ki;
#pragma unroll
                for (int q4 = 0; q4 < 4; ++q4) { const int off = (32 * tau + r32) * GQS + (32 * dl + 8 * q4 + 4 * hh) * 2;
                    const v2u qw = *(const LAS v2u*)(B + GLA_QOFF + off), kw = *(const LAS v2u*)(B + GLA_KOFF + off);
                    const float e0 = __builtin_amdgcn_exp2f(GT[4 * q4]), e1 = __builtin_amdgcn_exp2f(GT[4 * q4 + 1]), e2 = __builtin_amdgcn_exp2f(GT[4 * q4 + 2]), e3 = __builtin_amdgcn_exp2f(GT[4 * q4 + 3]);
                    qd[4 * q4] = bflo(qw.x) * e0; qd[4 * q4 + 1] = bfhi(qw.x) * e1; qd[4 * q4 + 2] = bflo(qw.y) * e2; qd[4 * q4 + 3] = bfhi(qw.y) * e3;
                    ki[4 * q4] = bflo(kw.x) * __builtin_amdgcn_rcpf(e0); ki[4 * q4 + 1] = bfhi(kw.x) * __builtin_amdgcn_rcpf(e1); ki[4 * q4 + 2] = bflo(kw.y) * __builtin_amdgcn_rcpf(e2); ki[4 * q4 + 3] = bfhi(kw.y) * __builtin_amdgcn_rcpf(e3); }
                fput(L + G2_QDF, (dl * 2 + tau) * 2 + 0, lane, pack8(qd, 0)); fput(L + G2_QDF, (dl * 2 + tau) * 2 + 1, lane, pack8(qd, 1));
                fput(L + G2_KIF, (dl * 2 + tau) * 2 + 0, lane, pack8(ki, 0)); fput(L + G2_KIF, (dl * 2 + tau) * 2 + 1, lane, pack8(ki, 1));
            } else {
                const int tau = (w >> 1) & 1, dl = w & 1;
                bf16x8 gf[4];
#pragma unroll
                for (int s = 0; s < 4; ++s) gf[s] = trfrag(B + GLA_GOFF + tr_qk + (16 * s) * GQS + dl * 64, 8 * GQS);
                f32x16 G1 = zero16(); G1 = MFMA32(ones, gf[0], G1); G1 = MFMA32(ones, gf[1], G1); G1 = MFMA32(Ua, gf[2], G1); G1 = MFMA32(Ub, gf[3], G1);
                const float gl_o = __shfl_xor(G1[15], 32); const float GL = hh ? G1[15] : gl_o;
                f32x16 Gt = G1;
                if (tau == 0) { Gt = zero16(); Gt = MFMA32(Ua, gf[0], Gt); Gt = MFMA32(Ub, gf[1], Gt); }
                else if (hh == 0) DEC[32 * dl + r32] = __builtin_amdgcn_exp2f(GL);
                f32x16 t16;
#pragma unroll
                for (int ks = 0; ks < 2; ++ks) { const bf16x8 kfr = trfrag(B + GLA_KOFF + tr_qk + (32 * tau + 16 * ks) * GQS + dl * 64, 8 * GQS);
#pragma unroll
                    for (int j = 0; j < 8; ++j) t16[8 * ks + j] = bfel(kfr, j) * __builtin_amdgcn_exp2f(GL - Gt[8 * ks + j]); }
                fput(L + G2_KTE, (tau * 2 + dl) * 2 + 0, lane, pack8(t16, 0)); fput(L + G2_KTE, (tau * 2 + dl) * 2 + 1, lane, pack8(t16, 1));
            }
            v2u zq[4];
#pragma unroll
            for (int q4 = 0; q4 < 4; ++q4) zq[q4] = *(const v2u*)(F.ZG + (((((size_t)(bh * 32 + c) * 2 + x) * 4 + vb) * 4 + q4) * 32 + r32) * 8 + 4 * hh);
            asm volatile("" ::: "memory");
            v4u st[5];
            if (more) gla_stage_load(Gb + (size_t)(c + 1) * 64 * 320, tid, st);
            G2_SYNC();
            bf16x8 vf[2][2];
#pragma unroll
            for (int tau = 0; tau < 2; ++tau)
#pragma unroll
                for (int ks = 0; ks < 2; ++ks) vf[tau][ks] = trfrag(B + GLA_VOFF + tr_v + (32 * tau + 16 * ks) * GVS + vb * 64, 8 * GVS);
            {
                f32x4 dq[4];
#pragma unroll
                for (int q4 = 0; q4 < 4; ++q4) dq[q4] = *(const LAS f32x4*)(DEC + 32 * x + 8 * q4 + 4 * hh);
#pragma unroll
                for (int e = 0; e < 16; ++e) S[e] *= dq[e >> 2][e & 3];
                bf16x8 kt[2][2];
#pragma unroll
                for (int tau = 0; tau < 2; ++tau)
#pragma unroll
                    for (int ks = 0; ks < 2; ++ks) kt[tau][ks] = fget(L + G2_KTE, (tau * 2 + x) * 2 + ks, lane);
#pragma unroll
                for (int tau = 0; tau < 2; ++tau)
#pragma unroll
                    for (int ks = 0; ks < 2; ++ks) S = MFMA32(kt[tau][ks], vf[tau][ks], S);
                LAS char* sfn = L + (((c + 1) & 1) ? G2_SF1 : G2_SF0);
                fput(sfn, (x * 4 + vb) * 2 + 0, lane, pack8(S, 0)); fput(sfn, (x * 4 + vb) * 2 + 1, lane, pack8(S, 1));
            }
            if (w < 3) {
                const int mu = (w == 1) ? 1 : 0, tau = (w == 0) ? 0 : 1;
                bf16x8 fa[2][2], fb[2][2];
#pragma unroll
                for (int dl = 0; dl < 2; ++dl)
#pragma unroll
                    for (int ks = 0; ks < 2; ++ks) { fa[dl][ks] = fget(L + G2_KIF, (dl * 2 + mu) * 2 + ks, lane); fb[dl][ks] = fget(L + G2_QDF, (dl * 2 + tau) * 2 + ks, lane); }
                f32x16 at = zero16(), at2 = zero16();
                at = MFMA32(fa[0][0], fb[0][0], at); at2 = MFMA32(fa[1][0], fb[1][0], at2); at = MFMA32(fa[0][1], fb[0][1], at); at2 = MFMA32(fa[1][1], fb[1][1], at2);
#pragma unroll
                for (int e = 0; e < 16; ++e) at[e] += at2[e];
                if (w < 2) {
#pragma unroll
                    for (int e = 0; e < 16; ++e) { const int m = (e & 3) + 8 * (e >> 2) + 4 * hh; at[e] = (m <= r32) ? at[e] : 0.f; } }
                fput(L + G2_ATF, w * 2 + 0, lane, pack8(at, 0)); fput(L + G2_ATF, w * 2 + 1, lane, pack8(at, 1));
            }
            G2_SYNC();
            f32x16 o = zero16(), o2 = zero16();
            {
                const LAS char* sfp = L + ((c & 1) ? G2_SF1 : G2_SF0);
                bf16x8 fs[2][2], fq[2][2], fa0, fa1, fa2 = ones, fa3 = ones;
#pragma unroll
                for (int dl = 0; dl < 2; ++dl)
#pragma unroll
                    for (int ks = 0; ks < 2; ++ks) { fs[dl][ks] = fget(sfp, (dl * 4 + vb) * 2 + ks, lane); fq[dl][ks] = fget(L + G2_QDF, (dl * 2 + x) * 2 + ks, lane); }
                if (x == 0) { fa0 = fget(L + G2_ATF, 0, lane); fa1 = fget(L + G2_ATF, 1, lane); }
                else { fa0 = fget(L + G2_ATF, 2, lane); fa1 = fget(L + G2_ATF, 3, lane); fa2 = fget(L + G2_ATF, 4, lane); fa3 = fget(L + G2_ATF, 5, lane); }
                const bf16x8 vx0 = x ? vf[1][0] : vf[0][0], vx1 = x ? vf[1][1] : vf[0][1];
                o = MFMA32(vx0, fa0, o); o2 = MFMA32(fs[0][0], fq[0][0], o2);
                o = MFMA32(vx1, fa1, o); o2 = MFMA32(fs[0][1], fq[0][1], o2);
                if (x == 1) { o = MFMA32(vf[0][0], fa2, o); o = MFMA32(vf[0][1], fa3, o); }
                o2 = MFMA32(fs[1][0], fq[1][0], o2); o2 = MFMA32(fs[1][1], fq[1][1], o2);
#pragma unroll
                for (int e = 0; e < 16; ++e) o[e] += o2[e];
            }
            float ssq = 0.f;
#pragma unroll
            for (int e = 0; e < 16; ++e) ssq += o[e] * o[e];
            ssq += __shfl_xor(ssq, 32);
            if (hh == 0) SS[(c & 1) * 256 + (32 * x + r32) * 4 + vb] = ssq;
            if (more) gla_stage_write(L + ((c + 1) & 1) * GLA_BUF, tid, st);
            G2_SYNC();
            const f32x4 s4 = *(const LAS f32x4*)(SS + (c & 1) * 256 + (32 * x + r32) * 4);
            const float rinv = 1.0f / sqrtf(((s4[0] + s4[1]) + (s4[2] + s4[3])) * (1.f / 128.f) + RMS_EPS);
            v2u wv[4];
#pragma unroll
            for (int q4 = 0; q4 < 4; ++q4) {
                wv[q4].x = pk2(o[4 * q4] * rinv * gq[q4][0] * bflo(zq[q4].x), o[4 * q4 + 1] * rinv * gq[q4][1] * bfhi(zq[q4].x));
                wv[q4].y = pk2(o[4 * q4 + 2] * rinv * gq[q4][2] * bflo(zq[q4].y), o[4 * q4 + 3] * rinv * gq[q4][3] * bfhi(zq[q4].y)); }
            bf16* op = F.A12 + trow * 1024 + h * 128 + 32 * vb + 8 * hh;
#pragma unroll
            for (int g = 0; g < 4; g += 2) {
                const auto rx = __builtin_amdgcn_permlane32_swap(wv[g].x, wv[g + 1].x, false, false);
                const auto ry = __builtin_amdgcn_permlane32_swap(wv[g].y, wv[g + 1].y, false, false);
                *(v4u*)(op + 8 * g) = (v4u){(unsigned)rx[0], (unsigned)ry[0], (unsigned)rx[1], (unsigned)ry[1]}; }
        }
    }
}
__device__ __forceinline__ void p0_xpass(Frame& F) {
    const int lane = F.lane, w = F.wave, tok = lane & 31, hh = lane >> 5;
    constexpr int XT_ROWB = 2064;
    LAS float* RED = (LAS float*)(F.lds + RING_OFF + 67584);
    bf16x8 w1f[8];
#pragma unroll
    for (int s = 0; s < 8; ++s) { float v[8];
#pragma unroll
        for (int j = 0; j < 8; ++j) v[j] = (tok < 16) ? F.w_in[(size_t)(128 * w + 16 * s + 8 * hh + j) * D_IN + 1024 + tok] : 0.f;
        v4u o; o.x = pk2(v[0], v[1]); o.y = pk2(v[2], v[3]); o.z = pk2(v[4], v[5]); o.w = pk2(v[6], v[7]); w1f[s] = __builtin_bit_cast(bf16x8, o); }
    bf16x8 w2f;
    { float v[8];
#pragma unroll
      for (int j = 0; j < 8; ++j) v[j] = F.w_gk2[(4 * hh + (j & 3) + 8 * (j >> 2)) * 256 + 32 * w + tok];
      v4u o; o.x = pk2(v[0], v[1]); o.y = pk2(v[2], v[3]); o.z = pk2(v[4], v[5]); o.w = pk2(v[6], v[7]); w2f = __builtin_bit_cast(bf16x8, o); }
    f32x4 bq[4];
#pragma unroll
    for (int q4 = 0; q4 < 4; ++q4) bq[q4] = *(const f32x4*)(F.b_gk + 32 * w + 8 * q4 + 4 * hh);
    const int crow0 = F.tid >> 7, ckc = F.tid & 127;
    LAS char* XT = (LAS char*)(F.lds + RING_OFF);
    f32x4 ld[8][2];
    { const float* xp = F.x + ((size_t)F.vcu * 32 + crow0) * D + 8 * ckc;
#pragma unroll
      for (int i = 0; i < 8; ++i) { ld[i][0] = __builtin_nontemporal_load((const GAS f32x4*)(xp + (size_t)i * 4 * D)); ld[i][1] = __builtin_nontemporal_load((const GAS f32x4*)(xp + (size_t)i * 4 * D + 4)); } }
    for (int blk = F.vcu; blk < M / 32; blk += F.G) {
        { bf16* xb = F.XB + ((size_t)blk * 32 + crow0) * D + 8 * ckc;
#pragma unroll
          for (int i = 0; i < 8; ++i) { v4u o; o.x = pk2(ld[i][0][0], ld[i][0][1]); o.y = pk2(ld[i][0][2], ld[i][0][3]); o.z = pk2(ld[i][1][0], ld[i][1][1]); o.w = pk2(ld[i][1][2], ld[i][1][3]);
              *(GAS v4u*)(xb + (size_t)i * 4 * D) = o; *(LAS v4u*)(XT + (crow0 + 4 * i) * XT_ROWB + ckc * 16) = o; } }
        if (blk + F.G < M / 32) { const float* xp = F.x + ((size_t)(blk + F.G) * 32 + crow0) * D + 8 * ckc;
#pragma unroll
            for (int i = 0; i < 8; ++i) { ld[i][0] = __builtin_nontemporal_load((const GAS f32x4*)(xp + (size_t)i * 4 * D)); ld[i][1] = __builtin_nontemporal_load((const GAS f32x4*)(xp + (size_t)i * 4 * D + 4)); } }
        __syncthreads();
        f32x16 acc = zero16();
        { bf16x8 xf[8];
#pragma unroll
          for (int s = 0; s < 8; ++s) xf[s] = *(const LAS bf16x8*)(XT + tok * XT_ROWB + (128 * w + 16 * s + 8 * hh) * 2);
#pragma unroll
          for (int s = 0; s < 8; ++s) acc = MFMA32(w1f[s], xf[s], acc); }
        LAS float* red = RED;
#pragma unroll
        for (int e = 0; e < 8; ++e) red[w * 512 + ((e & 3) + 8 * (e >> 2) + 4 * hh) * 32 + tok] = acc[e];
        __syncthreads();
        float r[8];
#pragma unroll
        for (int j = 0; j < 8; ++j) { const LAS float* q = red + ((j & 3) + 8 * (j >> 2) + 4 * hh) * 32 + tok;
            r[j] = ((q[0] + q[512]) + (q[1024] + q[1536])) + ((q[2048] + q[2560]) + (q[3072] + q[3584])); }
        v4u hi, lo;
        hi.x = pk2(r[0], r[1]); hi.y = pk2(r[2], r[3]); hi.z = pk2(r[4], r[5]); hi.w = pk2(r[6], r[7]);
        lo.x = pk2(r[0] - bflo(hi.x), r[1] - bfhi(hi.x)); lo.y = pk2(r[2] - bflo(hi.y), r[3] - bfhi(hi.y)); lo.z = pk2(r[4] - bflo(hi.z), r[5] - bfhi(hi.z)); lo.w = pk2(r[6] - bflo(hi.w), r[7] - bfhi(hi.w));
        f32x16 lg = zero16();
        lg = MFMA32(w2f, __builtin_bit_cast(bf16x8, hi), lg); lg = MFMA32(w2f, __builtin_bit_cast(bf16x8, lo), lg);
        v2u wv[4];
#pragma unroll
        for (int q4 = 0; q4 < 4; ++q4) {
            wv[q4].x = pk2(pg8::t_lg2(lg[4 * q4] + bq[q4][0]), pg8::t_lg2(lg[4 * q4 + 1] + bq[q4][1]));
            wv[q4].y = pk2(pg8::t_lg2(lg[4 * q4 + 2] + bq[q4][2]), pg8::t_lg2(lg[4 * q4 + 3] + bq[q4][3])); }
        const int m = blk * 32 + tok;
        bf16* op = F.HG + ((size_t)((m >> 11) * 4 + (w >> 1)) * SEQ + (m & (SEQ - 1))) * 320 + 128 + 32 * (w & 1) + 8 * hh;
#pragma unroll
        for (int g = 0; g < 4; g += 2) {
            const auto rx = __builtin_amdgcn_permlane32_swap(wv[g].x, wv[g + 1].x, false, false);
            const auto ry = __builtin_amdgcn_permlane32_swap(wv[g].y, wv[g + 1].y, false, false);
            __builtin_nontemporal_store((v4u){(unsigned)rx[0], (unsigned)ry[0], (unsigned)rx[1], (unsigned)ry[1]}, (v4u*)(op + 8 * g)); }
    }
    __syncthreads();
}
__device__ __forceinline__ void ln_rows(Frame& F) {
    const int gw = F.vcu * NWAVES + F.wave, NGW = F.G * NWAVES;
    f32x4 gv[4], bv[4];
#pragma unroll
    for (int j = 0; j < 4; ++j) { gv[j] = *((const f32x4*)F.ln_g + F.lane + 64 * j); bv[j] = *((const f32x4*)F.ln_b + F.lane + 64 * j); }
    for (int m = gw; m < M; m += NGW) {
        GAS f32x4* xr = (GAS f32x4*)(F.out + (size_t)m * D) + F.lane;
        const GAS f32x4* xi = (const GAS f32x4*)(F.x + (size_t)m * D) + F.lane; const GAS v2u* yi = (const GAS v2u*)(F.Yb + (size_t)m * D) + F.lane;
        f32x4 v[4]; float s = 0.f;
#pragma unroll
        for (int j = 0; j < 4; ++j) { const f32x4 xv = __builtin_nontemporal_load(xi + 64 * j); const v2u yw = __builtin_nontemporal_load(yi + 64 * j);
            v[j] = xv * ALPHA + (f32x4){bflo(yw.x), bfhi(yw.x), bflo(yw.y), bfhi(yw.y)}; s += (v[j].x + v[j].y) + (v[j].z + v[j].w); }
        const float mean = wave_sum(s) * (1.f / D); float s2 = 0.f;
#pragma unroll
        for (int j = 0; j < 4; ++j) { v[j] = v[j] - mean; s2 += (v[j].x * v[j].x + v[j].y * v[j].y) + (v[j].z * v[j].z + v[j].w * v[j].w); }
        const float rstd = 1.f / sqrtf(wave_sum(s2) * (1.f / D) + LN_EPS);
#pragma unroll
        for (int j = 0; j < 4; ++j) __builtin_nontemporal_store(v[j] * rstd * gv[j] + bv[j], xr + 64 * j);
    }
}

struct Args { const float* in[12]; float* out; unsigned char* ws; int ph_lo, ph_hi, li, pad; };
__global__ void __launch_bounds__(NWAVES * 64, 2) mk_fwd(Args args) {
    extern __shared__ __attribute__((aligned(16))) unsigned char lds[];
    Frame F;
    F.lds = (LAS unsigned char*)lds;
    F.MISC = (volatile LAS unsigned*)(F.lds + MISC_OFF);
    F.tid = threadIdx.x; F.lane = F.tid & 63; F.wave = __builtin_amdgcn_readfirstlane(F.tid >> 6);
    F.G = gridDim.x; { const int bx = blockIdx.x; F.vcu = (F.G % 8 == 0) ? (bx % 8) * (F.G / 8) + bx / 8 : bx; }
#define GRID_BAR(seam) do { if (N_LAUNCHES == PER_PHASE) { if (F.tid == 0) __hip_atomic_store(F.ctl + CW_TMO, 0xBADBA0u | (unsigned)(seam), RLX_AGENT); } \
    else { xcd_barrier(bar); } } while (0)
    unsigned char* ws = args.ws;
    F.ctl = (gu32*)(ws + WS_CTL);
    F.x = args.in[0]; F.w_in = args.in[1]; F.w_gk2 = args.in[2]; F.b_gk = args.in[3]; F.gla_norm_g = args.in[4]; F.w_o_gla = args.in[5];
    F.sinks = args.in[6]; F.w_o_swa = args.in[7]; F.b_gate = args.in[8]; F.w_out = args.in[9]; F.ln_g = args.in[10]; F.ln_b = args.in[11]; F.out = args.out;
    F.Win_t = (bf16*)(ws + WS_WIN); F.Wo12_t = (bf16*)(ws + WS_WO12); F.Wout_t = (bf16*)(ws + WS_WOUT);
    F.XB = (bf16*)(ws + WS_XB); F.A12 = (bf16*)(ws + WS_A12); F.H = (bf16*)(ws + WS_H); F.Mm = (bf16*)(ws + WS_MM); F.G8 = ws + WS_G8; F.HG = (bf16*)(ws + WS_HG); F.ZG = (bf16*)(ws + WS_ZG); F.ZS = (bf16*)(ws + WS_ZS); F.QS = (bf16*)(ws + WS_QS); F.Yb = (bf16*)(ws + WS_A12);
    for (int u = F.tid; u < (LDS_BYTES - LDSCTL_OFF) / 4; u += NWAVES * 64) ((LAS unsigned*)(F.lds + LDSCTL_OFF))[u] = 0u;
    __syncthreads();
    XcdBarrier bar; bar.bar = (unsigned*)(F.ctl + CW_BAR); bar.x = 0; bar.st = nullptr;
    if (N_LAUNCHES != PER_PHASE) bar = xcd_barrier_post((unsigned*)(F.ctl + CW_BAR), F.MISC + 8);
    const int lo = args.ph_lo, hi = args.ph_hi;
#define IN(k) (lo <= (k) && (k) < hi)
#define BOTH(k) (IN(k) && IN((k) + 1))

    if (IN(0)) { p0_xpass(F); p0_prologue(F); if (BOTH(0)) GRID_BAR(0); }

    if (IN(1)) {
        pg8::Gemm g{F.XB, F.Win_t, D, D, D}; pg8::SkipOrder S; S.init(M, pg8::NP1, F.G, (int)blockIdx.x, 2);
        pg8::Epi1 E{F.H, F.b_gk, F.b_gate, F.G8, F.HG, F.ZG, F.ZS, F.QS};
        pg8::gemm_phase<pg8::Epi1, pg8::SkipOrder, true, true>(F.lds + RING_OFF, g, S, E);
        if (BOTH(1)) GRID_BAR(1);
    }
    if (IN(2)) {
        gla_mfma2(F, F.G < 128 ? F.G : 128);
        __syncthreads();
        swa_mfma(F);
        if (BOTH(2)) GRID_BAR(2);
    }
    if (IN(3)) {
        pg8::Gemm g{F.A12, F.Wo12_t, 1024, 512, 512}; pg8::PairOrder S; S.init(M, D, F.G, (int)blockIdx.x);
        pg8::Epi3 E{F.Mm, F.G8};
        pg8::gemm_phase<pg8::Epi3, pg8::PairOrder, true, true>(F.lds + RING_OFF, g, S, E);
        if (BOTH(3)) GRID_BAR(3);
    }
    if (IN(4)) {
        pg8::Gemm g{F.Mm, F.Wout_t, D, D, D}; pg8::StaticOrder S; S.init(M, D, F.G, (int)blockIdx.x);
        pg8::Epi4 E{F.Yb};
        pg8::gemm_phase<pg8::Epi4, pg8::StaticOrder, true, true>(F.lds + RING_OFF, g, S, E);
        if (BOTH(4)) GRID_BAR(4);
    }
    if (IN(5)) { ln_rows(F); }
#undef IN
#undef BOTH
}

extern "C" void kernel_launch(void* const* d_in, const int* in_sizes, int n_in, void* d_out, int out_size, void* d_ws, size_t ws_size, hipStream_t stream) {
    static int grid = 0;
    if (grid == 0) {
        if (n_in != 12 || in_sizes[0] != M * D || out_size != M * D || ws_size < WS_END) { fprintf(stderr, "kernel_launch: unexpected shapes (n_in %d, in0 %d, out %d, ws %zu); nothing launched\n", n_in, n_in > 0 ? in_sizes[0] : -1, out_size, ws_size); grid = -1; return; }
        int dev = 0, cus = 0, per_cu = 0;
        if (hipGetDevice(&dev) != hipSuccess || hipDeviceGetAttribute(&cus, hipDeviceAttributeMultiprocessorCount, dev) != hipSuccess) { grid = -1; return; }
        if (hipFuncSetAttribute((const void*)mk_fwd, hipFuncAttributeMaxDynamicSharedMemorySize, LDS_BYTES) != hipSuccess) { fprintf(stderr, "kernel_launch: hipFuncSetAttribute failed\n"); grid = -1; return; }
        if (hipOccupancyMaxActiveBlocksPerMultiprocessor(&per_cu, (const void*)mk_fwd, NWAVES * 64, LDS_BYTES) != hipSuccess || per_cu < 1)
            fprintf(stderr, "kernel_launch: note: occupancy query reports %d workgroups per CU\n", per_cu);
        (void)hipGetLastError();
        grid = cus;
    }
    if (grid < 0) return;
    if (hipMemsetAsync((char*)d_ws + WS_CTL, 0, CTL_ZERO_BYTES, stream) != hipSuccess) { fprintf(stderr, "kernel_launch: hipMemsetAsync failed\n"); return; }
    Args a{};
    for (int i = 0; i < 12; ++i) a.in[i] = (const float*)d_in[i];
    a.out = (float*)d_out; a.ws = (unsigned char*)d_ws;
    for (int li = 0; li < N_LAUNCHES; ++li) {
        a.ph_lo = (N_LAUNCHES == PER_PHASE) ? li : 0; a.ph_hi = (N_LAUNCHES == PER_PHASE) ? li + 1 : PER_PHASE; a.li = li;
        hipLaunchKernelGGL(mk_fwd, dim3(grid), dim3(NWAVES * 64), LDS_BYTES, stream, a);
        const hipError_t le = hipPeekAtLastError();
        if (le != hipSuccess) { fprintf(stderr, "kernel_launch: launch %d failed: %s\n", li, hipGetErrorName(le)); break; }
    }
}
```

```cpp
#include <hip/hip_runtime.h>
#include <cstdio>
#include <cstdint>
namespace pg8 {
#define PG8_LAS __attribute__((address_space(3)))
typedef unsigned short bf16_t;
typedef short bf16x8 __attribute__((ext_vector_type(8)));
typedef float f32x4 __attribute__((ext_vector_type(4)));
typedef unsigned u32x4 __attribute__((ext_vector_type(4)));
constexpr int BM = 256, BK = 64, HALF = 128, HTB = HALF * BK * 2  , STAGE_BYTES = 8 * HTB, NXCD = 8, WGM = 2;

__host__ __device__ __forceinline__ int lds_byte(int r, int c) { const int st = (r >> 4) * 2 + (c >> 5), rr = r & 15, cc = c & 31, ob = rr * 64 + cc * 2; return st * 1024 + (ob ^ (((ob >> 9) & 1) << 5)); }
__host__ __device__ __forceinline__ void stage_rc(int b, int& R, int& C) { const int st = b / 1024, sb = b % 1024, swz = sb ^ (((sb >> 9) & 1) << 5); R = (st >> 1) * 16 + swz / 64; C = (st & 1) * 32 + (swz % 64) / 2; }
__host__ __device__ __forceinline__ int perm32(int rho) { const int n = rho >> 4, i = rho & 15; return 8 * (i >> 2) + 4 * n + (i & 3); }

struct Unit { int pm, pn, pb, acol; };
struct Gemm { const bf16_t* A; const bf16_t* Bt; int lda, ldb, K; };

template <int WGM_ = WGM>
__host__ __device__ __forceinline__ void tile_of(int L, int nM, int nN, int& pm, int& pn) {
    const int nwg = nM * nN; int wgid = L; { const int q = nwg / NXCD, r = nwg % NXCD, xcd = wgid % NXCD, off = wgid / NXCD; wgid = (xcd < r ? xcd * (q + 1) : r * (q + 1) + (xcd - r) * q) + off; }
    const int nig = WGM_ * nN, gid = wgid / nig, fm = gid * WGM_, gsz = (nM - fm) < WGM_ ? (nM - fm) : WGM_;
    pm = fm + ((wgid % nig) % gsz); pn = (wgid % nig) / gsz;
}
struct StaticOrder {
    int nM, nN, nwg, G, c;
    __host__ __device__ void init(int M, int N, int G_, int c_) { nM = M / BM; nN = N / BM; nwg = nM * nN; G = G_; c = c_; }
    __host__ __device__ bool next(int i, Unit& u) const {
        const long L = (long)i * G + c; if (L >= nwg) return false;
        tile_of((int)L, nM, nN, u.pm, u.pn); u.pb = u.pn; u.acol = 0; return true;
    }
    __device__ __forceinline__ void a_ready(const Unit&) const {}
    __device__ __forceinline__ void done(const Unit&) const {}
};
constexpr int P1_WGM = 1;
struct SkipOrder {
    int nM, nN, nwg, G, c, skip;
    __host__ __device__ void init(int M, int N, int G_, int c_, int skip_) { nM = M / BM; nN = N / BM - 1; nwg = nM * nN; G = G_; c = c_; skip = skip_; }
    __host__ __device__ bool next(int i, Unit& u) const {
        const long L = (long)i * G + c; if (L >= nwg) return false;
        tile_of<P1_WGM>((int)L, nM, nN, u.pm, u.pn); if (u.pn >= skip) ++u.pn; u.pb = u.pn; u.acol = 0; return true;
    }
    __device__ __forceinline__ void a_ready(const Unit&) const {}
    __device__ __forceinline__ void done(const Unit&) const {}
};
struct PairOrder {
    int nM, nN, nwg, G, c;
    __host__ __device__ void init(int M, int N, int G_, int c_) { nM = M / BM; nN = N / BM; nwg = nM * nN; G = G_; c = c_; }
    __host__ __device__ bool next(int i, Unit& u) const {
        const long L = (long)(i >> 1) * G + c; if (L >= nwg) return false;
        tile_of((int)L, nM, nN, u.pm, u.pn); const int which = i & 1; u.pb = 2 * u.pn + which; u.acol = which * 512 * 2; return true;
    }
    __device__ __forceinline__ void a_ready(const Unit&) const {}
    __device__ __forceinline__ void done(const Unit&) const {}
};

typedef float f32x2_t __attribute__((ext_vector_type(2))); typedef __bf16 bf16x2_t __attribute__((ext_vector_type(2)));
__device__ __forceinline__ unsigned cvt_pk_bf16(float lo, float hi) { f32x2_t v = {lo, hi}; bf16x2_t b = __builtin_convertvector(v, bf16x2_t); return __builtin_bit_cast(unsigned, b); }
__device__ __forceinline__ float bf_lo(unsigned w) { return __uint_as_float(w << 16); }
__device__ __forceinline__ float bf_hi(unsigned w) { return __uint_as_float(w & 0xffff0000u); }
constexpr float LOG2E = 1.4426950408889634f;
__device__ __forceinline__ float t_sigmoid(float v) { return __builtin_amdgcn_rcpf(1.f + __builtin_amdgcn_exp2f(-v * LOG2E)); }
__device__ __forceinline__ float t_silu(float v) { return v * t_sigmoid(v); }
__device__ __forceinline__ float t_lg2(float z) {
    const float a = __builtin_fabsf(z) * LOG2E;
    const float l = __builtin_amdgcn_logf(1.f + __builtin_amdgcn_exp2f(-a));
    return (__builtin_fminf(z, 0.f) * LOG2E - l) * 0.0625f;
}

constexpr int SH_N = 256, SH_KS = 0, SH_VS = 128;
constexpr int HC_QG = 0, HC_KG = 256, HC_LG = 512, HC_VG = 768, HC_ZG = 1280, HC_QS = 1792, HC_KS = 2304, HC_VS = 2432, HC_ZS = 2560, HC_GA = 3072, HC_GB = 4096, HN = 3072, NP1 = 5120;
constexpr int EPI_BUF0 = 3 * HTB, EPI_BUF1 = STAGE_BYTES + 1024;
template <class P>
__device__ __forceinline__ void staged_rows_bf16(PG8_LAS unsigned char* lds, bf16_t* tile, size_t ld, int wr, int wc, int fr, int fq, int wid, int lane, const P& piece) {
    asm volatile("" : "+v"(lane), "+v"(fr), "+v"(fq));
#pragma unroll
    for (int rr = 0; rr < 8; ++rr) { const int ai = rr >> 2, m = rr & 3; PG8_LAS unsigned char* buf = lds + ((rr & 1) ? EPI_BUF1 : EPI_BUF0);
        { const int row = wr * 16 + fr;
#pragma unroll
          for (int bj = 0; bj < 2; ++bj) { const int chunk = bj * 16 + wc * 4 + fq; *(PG8_LAS u32x4*)(buf + row * 512 + ((chunk ^ (row & 7)) * 16)) = piece(ai, m, bj); } }
        asm volatile("s_waitcnt lgkmcnt(0)" ::: "memory"); __builtin_amdgcn_s_barrier(); asm volatile("" ::: "memory");
#pragma unroll
        for (int i = 0; i < 2; ++i) { const int row = wid * 4 + i * 2 + (lane >> 5), chunk = lane & 31;
            const u32x4 v = *(const PG8_LAS u32x4*)(buf + row * 512 + ((chunk ^ (row & 7)) * 16));
            const int grow = ai * HALF + (row >> 4) * 64 + m * 16 + (row & 15);
            *(u32x4*)(tile + (size_t)grow * ld + chunk * 8) = v; }
    }
}
template <bool B> struct BoolC { static constexpr bool value = B; };
struct Epi1 {
    static constexpr bool PERM = true, AFTER_DRAIN = false, PAIRED = false;
    bf16_t* H; const float* b_gk; const float* b_gate; unsigned char* G8; bf16_t* HG; bf16_t* ZG; bf16_t* ZS; bf16_t* QS;
    static __device__ __forceinline__ u32x4 pack(const f32x4& v0, const f32x4& v1) { u32x4 w; w.x = cvt_pk_bf16(v0[0], v0[1]); w.y = cvt_pk_bf16(v0[2], v0[3]); w.z = cvt_pk_bf16(v1[0], v1[1]); w.w = cvt_pk_bf16(v1[2], v1[3]); return w; }
    __device__ __forceinline__ void operator()(const f32x4 (&acc)[2][2][4][2], const Unit& u, int wr, int wc, int fr, int fq, PG8_LAS unsigned char* lds, int wid, int lane) const {
        const int row0 = u.pm * BM + wr * 64 + fr, col0 = u.pn * BM + wc * 32 + 8 * fq;
        const int pn = u.pn;
        if (pn >= 12) {
            const float* bias = b_gate + (col0 - HC_GA);
            f32x4 bl[2][2];
#pragma unroll
            for (int bj = 0; bj < 2; ++bj)
#pragma unroll
                for (int n = 0; n < 2; ++n) { const f32x4 b4 = *(const f32x4*)(bias + bj * HALF + 4 * n);
#pragma unroll
                    for (int e = 0; e < 4; ++e) bl[bj][n][e] = __builtin_amdgcn_exp2f(b4[e] * -LOG2E) * (1.f / 255.f); }
            auto run = [&](auto clampc) {
#pragma unroll
            for (int ai = 0; ai < 2; ++ai)
#pragma unroll
                for (int m = 0; m < 4; ++m) { unsigned gw[4];
#pragma unroll
                    for (int bj = 0; bj < 2; ++bj)
#pragma unroll
                        for (int n = 0; n < 2; ++n) { unsigned p = 0u;
#pragma unroll
                            for (int e = 0; e < 4; ++e) {
                                float r = __builtin_amdgcn_rcpf(__builtin_fmaf(__builtin_amdgcn_exp2f(acc[ai][bj][m][n][e]), bl[bj][n][e], 1.f / 255.f));
                                if (decltype(clampc)::value) r = __builtin_fmaxf(r, 1.f);
                                p = __builtin_amdgcn_cvt_pk_u8_f32(r, e, p); }
                            gw[bj * 2 + n] = p; }
                    __builtin_nontemporal_store((u32x4){gw[0], gw[1], gw[2], gw[3]}, (u32x4*)(G8 + ((((size_t)(u.pm * 8 + (pn - 12)) * 8 + wid) * 8 + (ai * 4 + m)) * 64 + lane) * 16)); }
            };
            if (pn >= 16) run(BoolC<true>{}); else run(BoolC<false>{});
            return;
        }
        const bool silu = (pn == 5 || pn == 6 || pn == 10 || pn == 11);
        int goff[2] = {0, 0};
        if (pn < 5) {
#pragma unroll
            for (int bj = 0; bj < 2; ++bj) { const int c = wc * 32 + 8 * fq + bj * HALF;
                if (pn < 3) goff[bj] = (c >> 6) * (2048 * 320) + pn * 64 + (c & 63);
                else { const int cv = (pn - 3) * 256 + c; goff[bj] = (cv >> 7) * (2048 * 320) + 192 + (cv & 127); } }
        }
#pragma unroll
        for (int ai = 0; ai < 2; ++ai)
#pragma unroll
            for (int m = 0; m < 4; ++m) { const int mrow = row0 + ai * HALF + m * 16; bf16_t* rowp = H + (size_t)mrow * SH_N + (col0 - HC_KS);
                bf16_t* grow = HG + ((size_t)(mrow >> 11) * 4 * 2048 + (mrow & 2047)) * 320;
#pragma unroll
                for (int bj = 0; bj < 2; ++bj) { f32x4 v0 = acc[ai][bj][m][0], v1 = acc[ai][bj][m][1];
                    if (silu) {
#pragma unroll
                        for (int e = 0; e < 4; ++e) { v0[e] = v0[e] * __builtin_amdgcn_rcpf(1.f + __builtin_amdgcn_exp2f(v0[e])); v1[e] = v1[e] * __builtin_amdgcn_rcpf(1.f + __builtin_amdgcn_exp2f(v1[e])); } }
                    if (pn < 5) __builtin_nontemporal_store(pack(v0, v1), (u32x4*)(grow + goff[bj]));
                    else if (pn == 5 || pn == 6) {
                        const int cz = (pn - 5) * 256 + wc * 32 + 8 * fq + bj * HALF, hd = cz >> 7, v = cz & 127, t = mrow & 2047;
                        const size_t idx16 = ((((((size_t)((mrow >> 11) * 4 + hd) * 32 + (t >> 6)) * 2 + ((t >> 5) & 1)) * 4 + (v >> 5)) * 4 + ((v >> 3) & 3)) * 32 + (t & 31));
                        __builtin_nontemporal_store(pack(v0, v1), (u32x4*)(ZG + idx16 * 8)); }
                    else if (pn == 7 || pn == 8) {
                        const int cq = (pn - 7) * 256 + wc * 32 + 8 * fq + bj * HALF, hd = cq >> 6, d0 = cq & 63, t = mrow & 2047;
                        const size_t idx16 = ((((((size_t)((mrow >> 11) * 8 + hd) * 64 + (t >> 5)) * 4 + (d0 >> 4)) * 2 + ((d0 >> 3) & 1)) * 32 + (t & 31)));
                        __builtin_nontemporal_store(pack(v0, v1), (u32x4*)(QS + idx16 * 8)); }
                    else if (pn >= 10) {
                        const int cz = (pn - 10) * 256 + wc * 32 + 8 * fq + bj * HALF, hd = cz >> 6, t = mrow & 2047;
                        const size_t idx16 = (((((size_t)((mrow >> 11) * 8 + hd) * 64 + (t >> 5)) * 8 + ((cz & 63) >> 3)) * 32 + (t & 31)));
                        __builtin_nontemporal_store(pack(v0, v1), (u32x4*)(ZS + idx16 * 8)); }
                    else __builtin_nontemporal_store(pack(v0, v1), (u32x4*)(rowp + bj * HALF)); } }
    }
};
struct Epi3 {
    static constexpr bool PERM = true, AFTER_DRAIN = false, PAIRED = true;
    bf16_t* Mm; const unsigned char* G8;
    __device__ __forceinline__ void operator()(f32x4 (&acc)[2][2][4][2], const Unit& u, int wr, int wc, int fr, int fq, PG8_LAS unsigned char* lds, int wid, int lane) const {
        const int row0 = u.pm * BM + wr * 64 + fr, col0 = u.pn * BM + wc * 32 + 8 * fq; const int which = u.pb & 1;
        typedef unsigned u32x2 __attribute__((ext_vector_type(2)));
        int ln = lane; asm volatile("" : "+v"(ln));
        const unsigned char* gbase = G8 + (((size_t)(u.pm * 8 + u.pn) * 8 + wid) * 8 * 64 + ln) * 16;
        const unsigned char* gbb = gbase + (size_t)4 * 8 * 8 * 64 * 16;
        if (!which) {
            u32x4 gb[4], ga[4];
#pragma unroll
            for (int i = 0; i < 4; ++i) { gb[i] = __builtin_nontemporal_load((const u32x4*)(gbb + i * 1024)); ga[i] = __builtin_nontemporal_load((const u32x4*)(gbase + i * 1024)); }
            asm volatile("" ::: "memory");
#pragma unroll
            for (int ai = 0; ai < 2; ++ai)
#pragma unroll
                for (int m = 0; m < 4; ++m) { const u32x4 b4 = gb[m], a4 = ga[m];
                    if (ai == 0) { gb[m] = __builtin_nontemporal_load((const u32x4*)(gbb + (4 + m) * 1024)); ga[m] = __builtin_nontemporal_load((const u32x4*)(gbase + (4 + m) * 1024)); }
#pragma unroll
                    for (int bj = 0; bj < 2; ++bj) { const unsigned bx = bj ? b4.z : b4.x, by = bj ? b4.w : b4.y, ax = bj ? a4.z : a4.x, ay = bj ? a4.w : a4.y;
#pragma unroll
                        for (int e = 0; e < 4; ++e) { acc[ai][bj][m][0][e] *= (float)((ax >> (8 * e)) & 0xffu) * __builtin_amdgcn_rcpf((float)((bx >> (8 * e)) & 0xffu));
                                                      acc[ai][bj][m][1][e] *= (float)((ay >> (8 * e)) & 0xffu) * __builtin_amdgcn_rcpf((float)((by >> (8 * e)) & 0xffu)); } } }
        } else {
            u32x4 gb[8];
#pragma unroll
            for (int i = 0; i < 8; ++i) gb[i] = __builtin_nontemporal_load((const u32x4*)(gbb + i * 1024));
            asm volatile("" ::: "memory");
            staged_rows_bf16(lds, Mm + (size_t)u.pm * BM * 1024 + u.pn * BM, 1024, wr, wc, fr, fq, wid, lane, [&](int ai, int m, int bj) {
                const u32x4 b4 = gb[ai * 4 + m]; const unsigned bx = bj ? b4.z : b4.x, by = bj ? b4.w : b4.y; f32x4 v0 = acc[ai][bj][m][0], v1 = acc[ai][bj][m][1];
#pragma unroll
                for (int e = 0; e < 4; ++e) { v0[e] *= (float)((bx >> (8 * e)) & 0xffu); v1[e] *= (float)((by >> (8 * e)) & 0xffu); }
                u32x4 w; w.x = cvt_pk_bf16(v0[0], v0[1]); w.y = cvt_pk_bf16(v0[2], v0[3]); w.z = cvt_pk_bf16(v1[0], v1[1]); w.w = cvt_pk_bf16(v1[2], v1[3]); return w; });
        }
    }
};
struct Epi4 {
    static constexpr bool PERM = true, AFTER_DRAIN = false, PAIRED = false;
    bf16_t* Y;
    __device__ __forceinline__ void operator()(const f32x4 (&acc)[2][2][4][2], const Unit& u, int wr, int wc, int fr, int fq, PG8_LAS unsigned char* lds, int wid, int lane) const {
        staged_rows_bf16(lds, Y + (size_t)u.pm * BM * 1024 + u.pn * BM, 1024, wr, wc, fr, fq, wid, lane, [&](int ai, int m, int bj) {
            const f32x4 v0 = acc[ai][bj][m][0], v1 = acc[ai][bj][m][1];
            u32x4 w; w.x = cvt_pk_bf16(v0[0], v0[1]); w.y = cvt_pk_bf16(v0[2], v0[3]); w.z = cvt_pk_bf16(v1[0], v1[1]); w.w = cvt_pk_bf16(v1[2], v1[3]); return w; });
    }
};

template <class Epi, class Sched, bool ALIGN_EPI = false, bool SP2 = false>
__device__ __forceinline__ void gemm_phase(PG8_LAS unsigned char* lds, const Gemm g, const Sched& S, const Epi& E) {
    const int tid = threadIdx.x, wid = __builtin_amdgcn_readfirstlane(tid >> 6), lane = tid & 63, wr = wid >> 2, wc = wid & 3, fr = lane & 15, fq = lane >> 4;
    const int K = g.K, nt = K / BK;
    unsigned voffA[2], voffB[2];
#pragma unroll
    for (int i = 0; i < 2; ++i) { int R, C; stage_rc(tid * 16 + i * 8192, R, C); const int Rb = Epi::PERM ? ((R & ~31) + perm32(R & 31)) : R;
        voffA[i] = (unsigned)(R * g.lda + C) * 2u; voffB[i] = (unsigned)(Rb * g.ldb + C) * 2u; }
    const size_t kstep = (size_t)(BK * 2);
    const size_t hstepA = (size_t)HALF * g.lda * 2, hstepB = (size_t)HALF * g.ldb * 2;
    const size_t tstepA = 2 * hstepA, tstepB = 2 * hstepB;
    const unsigned ldsw = (unsigned)wid * 1024u;
    const int aoff = lds_byte(wr * 64 + fr, fq * 8), boff = lds_byte(wc * 32 + fr, fq * 8);
#define PG8_SA(b, h) (((b) * 2 + (h)) * HTB)
#define PG8_SB(b, h) ((4 + (b) * 2 + (h)) * HTB)
#define PG8_STAGE(bufoff, gbase, voff) do { _Pragma("unroll") for (int _i = 0; _i < 2; ++_i) \
        __builtin_amdgcn_global_load_lds((const unsigned*)((const char*)(gbase) + (voff)[_i]), (PG8_LAS unsigned*)(lds + (bufoff) + ldsw + _i * 8192), 16, 0, 0); } while (0)
#define PG8_LDA(dst, b, h) do { _Pragma("unroll") for (int m = 0; m < 4; ++m) _Pragma("unroll") for (int k = 0; k < 2; ++k) dst[m][k] = *(const PG8_LAS bf16x8*)(lds + PG8_SA(b, h) + aoff + m * 2048 + k * 1024); } while (0)
#define PG8_LDB(dst, b, h) do { _Pragma("unroll") for (int n = 0; n < 2; ++n) _Pragma("unroll") for (int k = 0; k < 2; ++k) dst[n][k] = *(const PG8_LAS bf16x8*)(lds + PG8_SB(b, h) + boff + n * 2048 + k * 1024); } while (0)
#define PG8_MMA(ai, bj, At, Bt) do { __builtin_amdgcn_s_setprio(1); _Pragma("unroll") for (int m = 0; m < 4; ++m) _Pragma("unroll") for (int n = 0; n < 2; ++n) _Pragma("unroll") for (int k = 0; k < 2; ++k) \
        acc[ai][bj][m][n] = __builtin_amdgcn_mfma_f32_16x16x32_bf16(Bt[n][k], At[m][k], acc[ai][bj][m][n], 0, 0, 0); __builtin_amdgcn_s_setprio(0); } while (0)
#define PG8_WAIT_V(n) asm volatile("s_waitcnt vmcnt(" #n ")" ::: "memory")
#define PG8_WAIT_L(n) asm volatile("s_waitcnt lgkmcnt(" #n ")" ::: "memory")
#define PG8_BAR __builtin_amdgcn_s_barrier()
#define PG8_SCHED __builtin_amdgcn_sched_barrier(0)
    Unit cur, nxt; int ui = 0;
    if (!S.next(0, cur)) return;
    f32x4 acc[2][2][4][2];
#pragma unroll
    for (int a = 0; a < 2; ++a)
#pragma unroll
        for (int b = 0; b < 2; ++b)
#pragma unroll
            for (int m = 0; m < 4; ++m)
#pragma unroll
                for (int n = 0; n < 2; ++n) acc[a][b][m][n] = (f32x4){0.f, 0.f, 0.f, 0.f};
    bf16x8 At[4][2], B0[2][2], B1[2][2];
    const char* cA = (const char*)g.A + (size_t)cur.pm * tstepA + cur.acol; const char* cB = (const char*)g.Bt + (size_t)cur.pb * tstepB;
    S.a_ready(cur);
    if constexpr (SP2) {
        PG8_STAGE(PG8_SB(0, 0), cB, voffB); PG8_STAGE(PG8_SB(0, 1), cB + hstepB, voffB); PG8_STAGE(PG8_SA(0, 0), cA, voffA); PG8_STAGE(PG8_SA(0, 1), cA + hstepA, voffA);
        if (wr == 1) PG8_BAR;
        PG8_WAIT_V(2); PG8_BAR;
        PG8_STAGE(PG8_SB(1, 0), cB + kstep, voffB); PG8_STAGE(PG8_SA(1, 0), cA + kstep, voffA); PG8_STAGE(PG8_SB(1, 1), cB + hstepB + kstep, voffB);
        PG8_WAIT_V(6); PG8_BAR;
    } else {
        PG8_STAGE(PG8_SB(0, 0), cB, voffB); PG8_STAGE(PG8_SA(0, 0), cA, voffA); PG8_STAGE(PG8_SB(0, 1), cB + hstepB, voffB); PG8_STAGE(PG8_SA(0, 1), cA + hstepA, voffA);
        if (wr == 1) PG8_BAR;
        PG8_WAIT_V(4); PG8_BAR;
        PG8_STAGE(PG8_SB(1, 0), cB + kstep, voffB); PG8_STAGE(PG8_SA(1, 0), cA + kstep, voffA); PG8_STAGE(PG8_SB(1, 1), cB + hstepB + kstep, voffB);
        PG8_WAIT_V(6); PG8_BAR;
    }
    for (;;) {
        const bool has_next = S.next(ui + 1, nxt);
        const char* nA = has_next ? (const char*)g.A + (size_t)nxt.pm * tstepA + nxt.acol : cA; const char* nB = has_next ? (const char*)g.Bt + (size_t)nxt.pb * tstepB : cB;
        for (int t = 0; t < nt; t += 2) {
            const bool last = (t == nt - 2);
            const char* a1 = cA + (size_t)(t + 1) * kstep;
            const char* a2 = last ? nA : cA + (size_t)(t + 2) * kstep; const char* b2 = last ? nB : cB + (size_t)(t + 2) * kstep;
            const char* a3 = a2 + kstep; const char* b3 = b2 + kstep;
            if (last && has_next) S.a_ready(nxt);
            if constexpr (SP2) {
            PG8_LDB(B0, 0, 0); PG8_LDB(B1, 0, 1); PG8_SCHED; PG8_LDA(At, 0, 0); PG8_STAGE(PG8_SA(1, 1), a1 + hstepA, voffA);
            PG8_WAIT_V(8); PG8_WAIT_L(0); PG8_BAR; PG8_MMA(0, 0, At, B0); PG8_MMA(0, 1, At, B1); PG8_BAR; PG8_SCHED;
            PG8_LDA(At, 0, 1); PG8_STAGE(PG8_SB(0, 0), b2, voffB); PG8_STAGE(PG8_SB(0, 1), b2 + hstepB, voffB); PG8_STAGE(PG8_SA(0, 0), a2, voffA);
            PG8_WAIT_V(8); PG8_WAIT_L(0); PG8_BAR; PG8_MMA(1, 0, At, B0); PG8_MMA(1, 1, At, B1); PG8_BAR; PG8_SCHED;
            PG8_LDB(B0, 1, 0); PG8_LDB(B1, 1, 1); PG8_SCHED; PG8_LDA(At, 1, 0); PG8_STAGE(PG8_SA(0, 1), a2 + hstepA, voffA);
            PG8_WAIT_V(8); PG8_WAIT_L(0); PG8_BAR; PG8_MMA(0, 0, At, B0); PG8_MMA(0, 1, At, B1); PG8_BAR; PG8_SCHED;
            PG8_LDA(At, 1, 1); PG8_STAGE(PG8_SB(1, 0), b3, voffB); PG8_STAGE(PG8_SB(1, 1), b3 + hstepB, voffB); PG8_STAGE(PG8_SA(1, 0), a3, voffA);
            PG8_WAIT_V(8); PG8_WAIT_L(0); PG8_BAR; PG8_MMA(1, 0, At, B0); PG8_MMA(1, 1, At, B1); PG8_BAR; PG8_SCHED;
            } else {
            PG8_LDB(B0, 0, 0); PG8_SCHED; PG8_LDA(At, 0, 0); PG8_STAGE(PG8_SA(1, 1), a1 + hstepA, voffA);
            PG8_WAIT_L(8); PG8_BAR; PG8_WAIT_L(0); PG8_MMA(0, 0, At, B0); PG8_BAR; PG8_SCHED;
            PG8_LDB(B1, 0, 1); PG8_STAGE(PG8_SB(0, 0), b2, voffB);
            PG8_BAR; PG8_WAIT_L(0); PG8_MMA(0, 1, At, B1); PG8_BAR;
            PG8_LDA(At, 0, 1); PG8_STAGE(PG8_SA(0, 0), a2, voffA);
            PG8_BAR; PG8_WAIT_L(0); PG8_MMA(1, 0, At, B0); PG8_BAR; PG8_SCHED;
            PG8_STAGE(PG8_SB(0, 1), b2 + hstepB, voffB);
            PG8_WAIT_V(6); PG8_BAR; PG8_MMA(1, 1, At, B1); PG8_BAR;
            PG8_LDB(B0, 1, 0); PG8_SCHED; PG8_LDA(At, 1, 0); PG8_STAGE(PG8_SA(0, 1), a2 + hstepA, voffA);
            PG8_WAIT_L(8); PG8_BAR; PG8_WAIT_L(0); PG8_MMA(0, 0, At, B0); PG8_BAR; PG8_SCHED;
            PG8_LDB(B1, 1, 1); PG8_STAGE(PG8_SB(1, 0), b3, voffB);
            PG8_BAR; PG8_WAIT_L(0); PG8_MMA(0, 1, At, B1); PG8_BAR;
            PG8_LDA(At, 1, 1); PG8_STAGE(PG8_SA(1, 0), a3, voffA);
            PG8_BAR; PG8_WAIT_L(0); PG8_MMA(1, 0, At, B0); PG8_BAR; PG8_SCHED;
            PG8_STAGE(PG8_SB(1, 1), b3 + hstepB, voffB);
            PG8_WAIT_V(6); PG8_BAR; PG8_MMA(1, 1, At, B1); PG8_BAR;
            }
        }
        if constexpr (ALIGN_EPI) { if (wr == 0) PG8_BAR; }
        if constexpr (!Epi::AFTER_DRAIN) { E(acc, cur, wr, wc, fr, fq, lds, wid, lane); S.done(cur); }
        if (!has_next) break;
        if (!Epi::PAIRED || (cur.pb & 1)) {
#pragma unroll
        for (int a = 0; a < 2; ++a)
#pragma unroll
            for (int b = 0; b < 2; ++b)
#pragma unroll
                for (int m = 0; m < 4; ++m)
#pragma unroll
                    for (int n = 0; n < 2; ++n) acc[a][b][m][n] = (f32x4){0.f, 0.f, 0.f, 0.f};
        }
        cur = nxt; cA = nA; cB = nB; ++ui;
        if constexpr (ALIGN_EPI) { if (wr == 1) PG8_BAR; }
    }
    PG8_WAIT_V(0);
    if constexpr (!ALIGN_EPI) { if (wr == 0) PG8_BAR; }
    PG8_BAR;
    if constexpr (Epi::AFTER_DRAIN) { E.fused(acc, cur, wr, wc, fr, fq, lds, wid, lane); S.done(cur); }
#undef PG8_SA
#undef PG8_SB
#undef PG8_STAGE
#undef PG8_LDA
#undef PG8_LDB
#undef PG8_MMA
#undef PG8_WAIT_V
#undef PG8_WAIT_L
#undef PG8_BAR
#undef PG8_SCHED
}
}

constexpr int NWAVES = 8;
#ifndef MK_N_LAUNCHES
#define MK_N_LAUNCHES 1
#endif
constexpr int N_LAUNCHES = MK_N_LAUNCHES;
constexpr int PER_PHASE = 6;

constexpr int BATCH = 32, SEQ = 2048, D = 1024, M = BATCH * SEQ;
constexpr int D_IN = 4880, HN = pg8::HN;
constexpr float LN_EPS = 1e-5f, RMS_EPS = 1e-6f, ALPHA = 1.189207115002721f;
using pg8::HC_QG; using pg8::HC_KG; using pg8::HC_LG; using pg8::HC_VG; using pg8::HC_ZG; using pg8::HC_QS; using pg8::HC_KS; using pg8::HC_VS; using pg8::HC_ZS; using pg8::HC_GA; using pg8::HC_GB;
using pg8::LOG2E;

constexpr size_t MiB = 1u << 20;
constexpr size_t WS_CTL = 0, CTL_ZERO_BYTES = 1 * MiB;
constexpr size_t WS_WIN = 2 * MiB;
constexpr size_t WS_WO12 = 12 * MiB;
constexpr size_t WS_WOUT = 14 * MiB;
constexpr size_t WS_XB = 16 * MiB;
constexpr size_t WS_MM = 464 * MiB;
constexpr size_t WS_A12 = 144 * MiB;
constexpr size_t WS_H = 272 * MiB;
constexpr size_t WS_QS = 304 * MiB;
constexpr size_t WS_ZS = 400 * MiB;
constexpr size_t WS_G8 = 656 * MiB;
constexpr size_t WS_HG = 784 * MiB;
constexpr size_t WS_ZG = 944 * MiB;
constexpr size_t WS_END = 1008 * MiB;
constexpr int CW_TMO = 0, CW_CODE = 1;
constexpr int CW_SWAQ = 2048;
constexpr int CW_BAR = 4096;

constexpr int RING_OFF = 0, RING_BYTES = 131072;
constexpr int LDSCTL_OFF = RING_BYTES, MISC_OFF = LDSCTL_OFF + 320;
constexpr int LDS_BYTES = 163840;
static_assert(MISC_OFF + 128 <= RING_BYTES + 1024 && RING_BYTES + 1024 + 16384 <= LDS_BYTES, "LDS map");

#define GAS __attribute__((address_space(1)))
#define LAS __attribute__((address_space(3)))
typedef unsigned short bf16;
typedef unsigned v4u __attribute__((ext_vector_type(4)));
typedef unsigned v2u __attribute__((ext_vector_type(2)));
typedef float f32x4 __attribute__((ext_vector_type(4)));
typedef GAS unsigned gu32;
typedef GAS unsigned long long gu64;
#define RLX_AGENT __ATOMIC_RELAXED, __HIP_MEMORY_SCOPE_AGENT
#define LDS_WAIT() asm volatile("s_waitcnt lgkmcnt(0)" ::: "memory")
#define VM_WAIT() asm volatile("s_waitcnt vmcnt(0)" ::: "memory")
__device__ __forceinline__ unsigned f2bf(float f) { unsigned u = __builtin_bit_cast(unsigned, f); return (u + 0x7fffu + ((u >> 16) & 1u)) >> 16; }
__device__ __forceinline__ unsigned pk2(float lo, float hi) { return pg8::cvt_pk_bf16(lo, hi); }
__device__ __forceinline__ float bflo(unsigned w) { return __uint_as_float(w << 16); }
__device__ __forceinline__ float bfhi(unsigned w) { return __uint_as_float(w & 0xffff0000u); }
__device__ __forceinline__ float bf1(bf16 h) { return __uint_as_float(((unsigned)h) << 16); }

#define XB_TMO      128
#define XB_XCNT(j)  (256  + 64 * (j))
#define XB_XSUB(j)  (1280 + 64 * (j))
#define XB_XGEN(j)  (2304 + 64 * (j))
#define XB_TOP      3328
#define XB_TOPGEN   3392
#define XCD_BAR_WORDS 3456
#define XB_SPIN_CAP (1u << 18)

__device__ __forceinline__ unsigned xb_ld(unsigned* p)              { return __hip_atomic_load(p, __ATOMIC_RELAXED, __HIP_MEMORY_SCOPE_AGENT); }
__device__ __forceinline__ unsigned xb_add(unsigned* p, unsigned v) { return __hip_atomic_fetch_add(p, v, __ATOMIC_RELAXED, __HIP_MEMORY_SCOPE_AGENT); }
__device__ __forceinline__ unsigned xb_xcc_id() { return (unsigned)__builtin_amdgcn_s_getreg((3 << 11) | 20) & 0xFu; }
#define XB_SPIN(cond, bar) do { unsigned _sp = 0; while (cond) { __builtin_amdgcn_s_sleep(1); \
    if ((++_sp & 255u) == 0u) { if (xb_ld(&(bar)[XB_TMO])) break; if (_sp > XB_SPIN_CAP) { atomicAdd(&(bar)[XB_TMO], 1u); break; } } } } while (0)

struct XcdBarrier {
    unsigned* bar; unsigned x;
    volatile LAS unsigned* st;
};

__device__ __forceinline__ XcdBarrier xcd_barrier_post(unsigned* bar, volatile LAS unsigned* st) {
    XcdBarrier b; b.bar = bar; b.x = xb_xcc_id(); b.st = st;
    if (threadIdx.x == 0) (void)xb_add(&bar[XB_XCNT(b.x)], 1u);
    return b;
}
__device__ __forceinline__ void xcd_barrier_complete(unsigned* bar, unsigned x, unsigned& nloc, unsigned& nx) {
    const unsigned G = gridDim.x * gridDim.y * gridDim.z;
    unsigned sum, cnt, mine, sp = 0u;
    for (;;) {
        sum = 0u; cnt = 0u; mine = 0u;
#pragma unroll
        for (unsigned j = 0; j < 16; ++j) { const unsigned c = xb_ld(&bar[XB_XCNT(j)]); sum += c; cnt += (c > 0u) ? 1u : 0u; mine = (j == x) ? c : mine; }
        if (sum == G) break;
        __builtin_amdgcn_s_sleep(1);
        if ((++sp & 255u) == 0u) { if (xb_ld(&bar[XB_TMO])) break; if (sp > XB_SPIN_CAP) { atomicAdd(&bar[XB_TMO], 1u); break; } }
    }
    nloc = mine > 0u ? mine : 1u; nx = cnt > 0u ? cnt : 1u;
}

__device__ __forceinline__ void xcd_barrier(const XcdBarrier& b) {
    asm volatile("s_waitcnt vmcnt(0)" ::: "memory");
    __syncthreads();
    if (threadIdx.x == 0) {
        unsigned* bar = b.bar;
        __builtin_amdgcn_s_waitcnt(0);
        unsigned nloc = b.st[0], nx = b.st[1];
        if (nloc == 0u) { xcd_barrier_complete(bar, b.x, nloc, nx); b.st[0] = nloc; b.st[1] = nx; }
        const unsigned old = xb_add(&bar[XB_XSUB(b.x)], 1u);
        const unsigned gen = old / nloc;
        if (old + 1u == (gen + 1u) * nloc) {
            __builtin_amdgcn_fence(__ATOMIC_RELEASE, "agent");
            asm volatile("s_waitcnt vmcnt(0)" ::: "memory");
            const unsigned og = xb_add(&bar[XB_TOP], 1u);
            const unsigned tg = og / nx;
            if (og + 1u == (tg + 1u) * nx) xb_add(&bar[XB_TOPGEN], 1u);
            else XB_SPIN(xb_ld(&bar[XB_TOPGEN]) == tg, bar);
            __builtin_amdgcn_fence(__ATOMIC_ACQUIRE, "agent");
            xb_add(&bar[XB_XGEN(b.x)], 1u);
            asm volatile("s_waitcnt vmcnt(0)" ::: "memory");
        } else {
            XB_SPIN(xb_ld(&bar[XB_XGEN(b.x)]) == gen, bar);
            __builtin_amdgcn_fence(__ATOMIC_ACQUIRE, "agent");
            asm volatile("s_waitcnt vmcnt(0)" ::: "memory");
        }
    }
    __syncthreads();
}

struct Frame {
    LAS unsigned char* lds;
    volatile LAS unsigned* MISC;
    gu32* ctl;
    int tid, lane, wave;
    int vcu, G;
    const float *x, *w_in, *w_gk2, *b_gk, *gla_norm_g, *w_o_gla, *sinks, *w_o_swa, *b_gate, *w_out, *ln_g, *ln_b; float* out;
    bf16 *Win_t, *Wo12_t, *Wout_t, *XB, *A12, *H, *Mm, *Yb, *HG, *ZG, *ZS, *QS; unsigned char* G8;
};
__device__ __forceinline__ float wave_sum(float v) {
#pragma unroll
    for (int o = 1; o < 64; o <<= 1) v += __shfl_xor(v, o);
    return v;
}
__device__ __forceinline__ void tr_item(const float* W, int ldw, int s0, int k0, bf16* WT, int ldt, int drow0, LAS float* scr, int lane, float sc = 1.f) {
    float wv[32];
#pragma unroll
    for (int i = 0; i < 32; ++i) wv[i] = W[(size_t)(k0 + 2 * i + (lane >> 5)) * ldw + s0 + (lane & 31)];
#pragma unroll
    for (int i = 0; i < 32; ++i) scr[(2 * i + (lane >> 5)) * 33 + (lane & 31)] = wv[i] * sc;
    LDS_WAIT(); asm volatile("" ::: "memory");
    const int c = lane & 7;
#pragma unroll
    for (int j = 0; j < 4; ++j) { const int n = (lane >> 3) + 8 * j; const LAS float* s = scr + (8 * c) * 33 + n;
        v4u o; o.x = pk2(s[0 * 33], s[1 * 33]); o.y = pk2(s[2 * 33], s[3 * 33]); o.z = pk2(s[4 * 33], s[5 * 33]); o.w = pk2(s[6 * 33], s[7 * 33]);
        *(GAS v4u*)(WT + (size_t)(drow0 + n) * ldt + k0 + 8 * c) = o; }
    LDS_WAIT(); asm volatile("" ::: "memory");
}
__device__ __forceinline__ int win_src_col(int n) {
    if (n < 512) return n;
    if (n < 1280) return n - 768 + 512;
    if (n < 1792) return n - 1280 + 1040;
    if (n < 2304) return n - 1792 + 1552;
    if (n < 2432) return n - 2304 + 2064;
    if (n < 2560) return n - 2432 + 2192;
    if (n < 3072) return n - 2560 + 2320;
    return n - 3072 + 2832;
}
__device__ __forceinline__ void p0_prologue(Frame& F) {
    LAS float* scr = (LAS float*)(F.lds + RING_OFF + F.wave * 16384);
    const int gw = F.vcu * NWAVES + F.wave, NGW = F.G * NWAVES;
    constexpr int I_IN = 16 * 152, I_OG = 8 * 32, I_OS = 8 * 32, I_OUT = 16 * 32;
    constexpr int NITEMS = I_IN + I_OG + I_OS + I_OUT;
    for (int it = gw; it < NITEMS; it += NGW) {
        int r = it;
        if (r < I_IN) { const int kb = r / 152; int nb = r % 152; if (nb >= 16) nb += 8;
            const int hc = 32 * nb; const bool ecol = (hc >= HC_GA) || (hc >= HC_ZG && hc < HC_QS) || (hc >= HC_ZS && hc < HC_GA);
            const float qsc = (hc < HC_KG) ? 0.125f : ((hc >= HC_QS && hc < HC_KS) ? 0.125f * LOG2E : 1.f);
            tr_item(F.w_in, D_IN, win_src_col(hc), 64 * kb, F.Win_t, D, hc, scr, F.lane, ecol ? -LOG2E : qsc); continue; }
        r -= I_IN;
        if (r < I_OG) { const int kb = r >> 5, nb = r & 31; tr_item(F.w_o_gla, D, 32 * nb, 64 * kb, F.Wo12_t, 512, (2 * (nb >> 3)) * 256 + 32 * (nb & 7), scr, F.lane); continue; }
        r -= I_OG;
        if (r < I_OS) { const int kb = r >> 5, nb = r & 31; tr_item(F.w_o_swa, D, 32 * nb, 64 * kb, F.Wo12_t, 512, (2 * (nb >> 3) + 1) * 256 + 32 * (nb & 7), scr, F.lane); continue; }
        r -= I_OS;
        { const int kb = r >> 5, nb = r & 31; tr_item(F.w_out, D, 32 * nb, 64 * kb, F.Wout_t, D, 32 * nb, scr, F.lane, 1.f / 255.f); }
    }
}
typedef short bf16x8 __attribute__((ext_vector_type(8)));
typedef short s16x4 __attribute__((ext_vector_type(4)));
typedef float f32x16 __attribute__((ext_vector_type(16)));
__device__ __forceinline__ s16x4 vtr(const LAS char* p) { return __builtin_bit_cast(s16x4, __builtin_amdgcn_ds_read_tr16_b64_v4i16((LAS s16x4*)p)); }
__device__ __forceinline__ bf16x8 pack8(const f32x16& x, int s) {
    v4u p; p.x = pk2(x[8 * s], x[8 * s + 1]); p.y = pk2(x[8 * s + 2], x[8 * s + 3]); p.z = pk2(x[8 * s + 4], x[8 * s + 5]); p.w = pk2(x[8 * s + 6], x[8 * s + 7]);
    return __builtin_bit_cast(bf16x8, p);
}
__device__ __forceinline__ f32x16 zero16() { f32x16 z;
#pragma unroll
    for (int e = 0; e < 16; ++e) z[e] = 0.f;
    return z; }
#define MFMA32(a, b, c) __builtin_amdgcn_mfma_f32_32x32x16_bf16((a), (b), (c), 0, 0, 0)
constexpr int SWS = 144, SWA_KOFF = 0, SWA_VOFF = 256 * SWS, SWA_QW = 2 * 256 * SWS, SWA_OST = SWA_QW + 256, SWA_NITEMS = BATCH * 2 * (SEQ / 128);
static_assert(SWA_OST + 8 * 4096 <= RING_BYTES, "SWA LDS map");
__device__ __forceinline__ void swa_stage_load(Frame& F, int item, v4u (&kr)[4], v4u (&vr)[4]) {
    const int n = item & 15, kvh = (item >> 4) & 1, b = item >> 5;
#pragma unroll
    for (int i = 0; i < 4; ++i) { const int p = F.tid + 512 * i, row = p >> 3, pc = p & 7; int key = 128 * (n - 1) + row; key = key < 0 ? 0 : key;
        const bf16* src = F.H + (size_t)(b * SEQ + key) * pg8::SH_N + kvh * 64 + pc * 8;
        kr[i] = *(const v4u*)(src + pg8::SH_KS); vr[i] = *(const v4u*)(src + pg8::SH_VS); }
}
__device__ __forceinline__ void swa_stage_write(Frame& F, LAS char* L, const v4u (&kr)[4], const v4u (&vr)[4]) {
#pragma unroll
    for (int i = 0; i < 4; ++i) { const int p = F.tid + 512 * i, row = p >> 3, pc = p & 7;
        *(LAS v4u*)(L + SWA_KOFF + row * SWS + pc * 16) = kr[i]; *(LAS v4u*)(L + SWA_VOFF + row * SWS + pc * 16) = vr[i]; }
}
__device__ __forceinline__ void swa_compute(Frame& F, int lane, int item, const LAS char* L) {
    const int n = item & 15, kvh = (item >> 4) & 1, b = item >> 5;
    const int r32 = lane & 31, hh = lane >> 5, sb = F.wave & 3;
    const int qb32 = 4 * n + sb, t0 = qb32 * 32;
    const bf16* Hb = F.H + (size_t)b * SEQ * pg8::SH_N;
    const int trq = (lane & 15) >> 2, trp = lane & 3, trg = (lane >> 4) & 1;
    const LAS char* vrd = L + SWA_VOFF + (4 * hh + trq) * SWS + (16 * trg + 4 * trp) * 2;
    const LAS char* krd = L + SWA_KOFF + r32 * SWS + 16 * hh;
    const int ibase = r32 - 4 * hh; const float fbase = (float)ibase;
#pragma unroll 1
    for (int gi = 0; gi < 2; ++gi) {
        const int h = kvh * 4 + 2 * (F.wave >> 2) + gi;
        const float slope2 = __builtin_amdgcn_exp2f(-(float)(h + 1)) * LOG2E, sink2 = F.sinks[h] * LOG2E;
        const float nslope2 = -slope2;
        bf16x8 qf[4];
        { const bf16* qp = F.QS + (((size_t)(b * 8 + h) * 64 + qb32) * 4 * 2 * 32 + lane) * 8;
#pragma unroll
          for (int ds = 0; ds < 4; ++ds) qf[ds] = *(const bf16x8*)(qp + (size_t)ds * 2 * 32 * 8); }
        const size_t row = (size_t)b * SEQ + t0 + r32;
        v2u zq[8];
        { const bf16* zp = F.ZS + ((((size_t)(b * 8 + h) * 64 + qb32) * 8) * 32 + r32) * 8 + 4 * hh;
#pragma unroll
          for (int i = 0; i < 8; ++i) zq[i] = *(const v2u*)(zp + (size_t)i * 32 * 8); }
        f32x16 sc[5]; float mx = sink2;
#pragma unroll
        for (int r = 0; r < 5; ++r) {
            const int c = qb32 - 4 + r;
            if (c >= 0) {
                f32x16 acc = zero16();
#pragma unroll
                for (int ds = 0; ds < 4; ++ds) { const bf16x8 kf = *(const LAS bf16x8*)(krd + (32 * (sb + r)) * SWS + 32 * ds); acc = MFMA32(kf, qf[ds], acc); }
                float a0 = nslope2 * (fbase + (float)(128 - 32 * r)); asm volatile("" : "+v"(a0));
#pragma unroll
                for (int e = 0; e < 16; ++e) {
                    const int ce = (e & 3) + 8 * (e >> 2);
                    float s = __builtin_fmaf(slope2, (float)ce, acc[e] + a0);
                    if (r == 0) s = (ibase < ce) ? s : -INFINITY;
                    if (r == 4) s = (ibase >= ce) ? s : -INFINITY;
                    sc[r][e] = s; mx = __builtin_fmaxf(mx, s); }
            } else {
#pragma unroll
                for (int e = 0; e < 16; ++e) sc[r][e] = -INFINITY;
            }
        }
        mx = __builtin_fmaxf(mx, __shfl_xor(mx, 32));
        float l = 0.f;
        bf16x8 pbs[5][2];
#pragma unroll
        for (int r = 0; r < 5; ++r) {
#pragma unroll
            for (int e = 0; e < 16; ++e) { const float p = __builtin_amdgcn_exp2f(sc[r][e] - mx); sc[r][e] = p; l += p; }
            pbs[r][0] = pack8(sc[r], 0); pbs[r][1] = pack8(sc[r], 1); }
        l += __shfl_xor(l, 32); l += __builtin_amdgcn_exp2f(sink2 - mx);
        f32x16 o[2]; o[0] = zero16(); o[1] = zero16();
#pragma unroll
        for (int r = 0; r < 5; ++r) {
            const int c = qb32 - 4 + r;
            if (c >= 0) {
#pragma unroll
                for (int s = 0; s < 2; ++s) { const bf16x8 pb = pbs[r][s];
#pragma unroll
                    for (int db = 0; db < 2; ++db) {
                        const s16x4 lo = vtr(vrd + (32 * (sb + r) + 16 * s) * SWS + db * 64), hi = vtr(vrd + (32 * (sb + r) + 16 * s + 8) * SWS + db * 64);
                        const bf16x8 vf = __builtin_shufflevector(lo, hi, 0, 1, 2, 3, 4, 5, 6, 7);
                        o[db] = MFMA32(vf, pb, o[db]); } }
            }
        }
        const float il = -0.6931471805599453f * __builtin_amdgcn_rcpf(l); LAS char* ost = (LAS char*)L + SWA_OST + F.wave * 4096;
#pragma unroll
        for (int db = 0; db < 2; ++db)
#pragma unroll
            for (int q4 = 0; q4 < 4; ++q4) { const int d = 32 * db + 8 * q4 + 4 * hh; const v2u z = zq[4 * db + q4]; v2u w;
                w.x = pk2(o[db][4 * q4] * il * bflo(z.x), o[db][4 * q4 + 1] * il * bfhi(z.x)); w.y = pk2(o[db][4 * q4 + 2] * il * bflo(z.y), o[db][4 * q4 + 3] * il * bfhi(z.y));
                *(LAS v2u*)(ost + r32 * 128 + ((2 * d) ^ ((r32 & 7) << 4))) = w; }
        bf16* op = F.A12 + ((size_t)b * SEQ + t0) * 1024 + 512 + h * 64;
#pragma unroll
        for (int i = 0; i < 4; ++i) { const int rr = 8 * i + (lane >> 3), ch = lane & 7;
            const v4u v = *(const LAS v4u*)(ost + rr * 128 + ((ch ^ (rr & 7)) << 4));
            *(v4u*)(op + (size_t)rr * 1024 + ch * 8) = v; }
    }
}
__device__ __forceinline__ void swa_mfma(Frame& F) {
    LAS char* L = (LAS char*)(F.lds + RING_OFF);
    volatile LAS int* qw = (volatile LAS int*)(L + SWA_QW);
    int lane = F.lane; asm volatile("" : "+v"(lane));
    if (F.tid == 0) { qw[0] = (int)__hip_atomic_fetch_add((unsigned*)(F.ctl + CW_SWAQ), 1u, __ATOMIC_RELAXED, __HIP_MEMORY_SCOPE_AGENT);
                      qw[1] = (int)__hip_atomic_fetch_add((unsigned*)(F.ctl + CW_SWAQ), 1u, __ATOMIC_RELAXED, __HIP_MEMORY_SCOPE_AGENT); }
    __syncthreads();
    int item = qw[0], next = qw[1];
    v4u kr[4], vr[4];
    if (item < SWA_NITEMS) swa_stage_load(F, item, kr, vr);
    while (item < SWA_NITEMS) {
        swa_stage_write(F, L, kr, vr);
        int nn = 0;
        if (F.tid == 0) nn = (int)__hip_atomic_fetch_add((unsigned*)(F.ctl + CW_SWAQ), 1u, __ATOMIC_RELAXED, __HIP_MEMORY_SCOPE_AGENT);
        __syncthreads();
        if (next < SWA_NITEMS) swa_stage_load(F, next, kr, vr);
        int ln = lane; asm volatile("" : "+v"(ln));
        swa_compute(F, ln, item, L);
        if (F.tid == 0) qw[2] = nn;
        __syncthreads();
        item = next; next = qw[2];
    }
}
constexpr int GQS = 136, GVS = 264, GLA_QOFF = 0, GLA_KOFF = 64 * GQS, GLA_GOFF = 2 * 64 * GQS, GLA_VOFF = 3 * 64 * GQS, GLA_BUF = 3 * 64 * GQS + 64 * GVS;
constexpr int GLA_SS = 2 * GLA_BUF, GLA_SCR = GLA_SS + 2 * 64 * 4 * 4;
static_assert(GLA_SCR + 8 * 256 <= RING_BYTES, "GLA LDS map");
__device__ __forceinline__ bf16x8 trfrag(const LAS char* p, int rs8) { const s16x4 lo = vtr(p), hi = vtr(p + rs8); return __builtin_shufflevector(lo, hi, 0, 1, 2, 3, 4, 5, 6, 7); }
__device__ __forceinline__ float bfel(const bf16x8& f, int j) { return __uint_as_float(((unsigned)(unsigned short)f[j]) << 16); }
__device__ __forceinline__ void gla_stage_load(const bf16* chunk, int tid, v4u (&st)[5]) {
#pragma unroll
    for (int i = 0; i < 5; ++i) st[i] = *(const v4u*)(chunk + (size_t)(tid + 512 * i) * 8);
}
__device__ __forceinline__ void gla_stage_write(LAS char* buf, int tid, const v4u (&st)[5]) {
#pragma unroll
    for (int i = 0; i < 5; ++i) { const int p = tid + 512 * i, row = p / 40, pp = p - row * 40;
        LAS char* dst = (pp < 24) ? buf + (pp >> 3) * 64 * GQS + row * GQS + (pp & 7) * 16 : buf + GLA_VOFF + row * GVS + (pp - 24) * 16;
        *(LAS v2u*)dst = (v2u){st[i].x, st[i].y}; *(LAS v2u*)(dst + 8) = (v2u){st[i].z, st[i].w}; }
}
constexpr int G2_QDF = 2 * GLA_BUF, G2_KIF = G2_QDF + 8192, G2_KTE = G2_KIF + 8192, G2_SF0 = G2_KTE + 8192;
constexpr int G2_HI = RING_BYTES + 1024, G2_SF1 = G2_HI, G2_ATF = G2_SF1 + 16384, G2_DEC = G2_ATF + 6144, G2_SS = G2_DEC + 256;
static_assert(G2_SF0 + 16384 <= RING_BYTES && G2_SS + 2048 <= LDS_BYTES, "GLA v2 LDS map");
__device__ __forceinline__ void fput(LAS char* base, int idx, int lane, const bf16x8& f) { *(LAS bf16x8*)(base + idx * 1024 + lane * 16) = f; }
__device__ __forceinline__ bf16x8 fget(const LAS char* base, int idx, int lane) { return *(const LAS bf16x8*)(base + idx * 1024 + lane * 16); }
#define G2_SYNC() do { asm volatile("s_waitcnt lgkmcnt(0)" ::: "memory"); __builtin_amdgcn_s_barrier(); asm volatile("" ::: "memory"); } while (0)
__device__ __forceinline__ void gla_mfma2(Frame& F, int n_wg) {
    if ((int)blockIdx.x >= n_wg) return;
    const int tid = F.tid, lane = F.lane, r32 = lane & 31, hh = lane >> 5, w = F.wave, x = w >> 2, vb = w & 3;
    const int trq = (lane & 15) >> 2, trp = lane & 3, trg = (lane >> 4) & 1;
    const int tr_qk = (4 * hh + trq) * GQS + (16 * trg + 4 * trp) * 2, tr_v = (4 * hh + trq) * GVS + (16 * trg + 4 * trp) * 2;
    LAS char* L = (LAS char*)(F.lds + RING_OFF);
    LAS float* SS = (LAS float*)(L + G2_SS); LAS float* DEC = (LAS float*)(L + G2_DEC);
    bf16x8 Ua, Ub, ones;
#pragma unroll
    for (int j = 0; j < 8; ++j) { const int s0 = 8 * (j >> 2) + 4 * hh + (j & 3); Ua[j] = (s0 <= r32) ? (short)0x3F80 : (short)0; Ub[j] = (16 + s0 <= r32) ? (short)0x3F80 : (short)0; ones[j] = (short)0x3F80; }
    f32x4 gq[4];
#pragma unroll
    for (int q4 = 0; q4 < 4; ++q4) gq[q4] = *(const f32x4*)(F.gla_norm_g + 32 * vb + 8 * q4 + 4 * hh) * (-0.6931471805599453f);
    for (int bh = blockIdx.x; bh < BATCH * 4; bh += n_wg) {
        const int b = bh >> 2, h = bh & 3;
        const bf16* Gb = F.HG + (size_t)bh * SEQ * 320;
        __syncthreads();
        { v4u st[5]; gla_stage_load(Gb, tid, st); gla_stage_write(L, tid, st); }
        { bf16x8 z8;
#pragma unroll
          for (int j = 0; j < 8; ++j) z8[j] = 0;
          fput(L + G2_SF0, (x * 4 + vb) * 2 + 0, lane, z8); fput(L + G2_SF0, (x * 4 + vb) * 2 + 1, lane, z8); }
        __syncthreads();
        f32x16 S = zero16();
        for (int c = 0; c < SEQ / 64; ++c) {
            const LAS char* B = L + (c & 1) * GLA_BUF;
            const size_t trow = (size_t)b * SEQ + c * 64 + 32 * x + r32;
            const bool more = (c + 1 < SEQ / 64);
            if (w < 4) {
                const int dl = w >> 1, tau = w & 1;
                f32x16 GT = zero16();
                { const bf16x8 g0 = trfrag(B + GLA_GOFF + tr_qk + dl * 64, 8 * GQS), g1 = trfrag(B + GLA_GOFF + tr_qk + 16 * GQS + dl * 64, 8 * GQS);
                  if (tau == 0) { GT = MFMA32(g0, Ua, GT); GT = MFMA32(g1, Ub, GT); }
                  else { const bf16x8 g2 = trfrag(B + GLA_GOFF + tr_qk + 32 * GQS + dl * 64, 8 * GQS), g3 = trfrag(B + GLA_GOFF + tr_qk + 48 * GQS + dl * 64, 8 * GQS);
                         GT = MFMA32(g0, ones, GT); GT = MFMA32(g1, ones, GT); GT = MFMA32(g2, Ua, GT); GT = MFMA32(g3, Ub, GT); } }
                f32x16 qd, ki;
#pragma unroll
                for (int q4 = 0; q4 < 4; ++q4) { const int off = (32 * tau + r32) * GQS + (32 * dl + 8 * q4 + 4 * hh) * 2;
                    const v2u qw = *(const LAS v2u*)(B + GLA_QOFF + off), kw = *(const LAS v2u*)(B + GLA_KOFF + off);
                    const float e0 = __builtin_amdgcn_exp2f(GT[4 * q4]), e1 = __builtin_amdgcn_exp2f(GT[4 * q4 + 1]), e2 = __builtin_amdgcn_exp2f(GT[4 * q4 + 2]), e3 = __builtin_amdgcn_exp2f(GT[4 * q4 + 3]);
                    qd[4 * q4] = bflo(qw.x) * e0; qd[4 * q4 + 1] = bfhi(qw.x) * e1; qd[4 * q4 + 2] = bflo(qw.y) * e2; qd[4 * q4 + 3] = bfhi(qw.y) * e3;
                    ki[4 * q4] = bflo(kw.x) * __builtin_amdgcn_rcpf(e0); ki[4 * q4 + 1] = bfhi(kw.x) * __builtin_amdgcn_rcpf(e1); ki[4 * q4 + 2] = bflo(kw.y) * __builtin_amdgcn_rcpf(e2); ki[4 * q4 + 3] = bfhi(kw.y) * __builtin_amdgcn_rcpf(e3); }
                fput(L + G2_QDF, (dl * 2 + tau) * 2 + 0, lane, pack8(qd, 0)); fput(L + G2_QDF, (dl * 2 + tau) * 2 + 1, lane, pack8(qd, 1));
                fput(L + G2_KIF, (dl * 2 + tau) * 2 + 0, lane, pack8(ki, 0)); fput(L + G2_KIF, (dl * 2 + tau) * 2 + 1, lane, pack8(ki, 1));
            } else {
                const int tau = (w >> 1) & 1, dl = w & 1;
                bf16x8 gf[4];
#pragma unroll
                for (int s = 0; s < 4; ++s) gf[s] = trfrag(B + GLA_GOFF + tr_qk + (16 * s) * GQS + dl * 64, 8 * GQS);
                f32x16 G1 = zero16(); G1 = MFMA32(ones, gf[0], G1); G1 = MFMA32(ones, gf[1], G1); G1 = MFMA32(Ua, gf[2], G1); G1 = MFMA32(Ub, gf[3], G1);
                const float gl_o = __shfl_xor(G1[15], 32); const float GL = hh ? G1[15] : gl_o;
                f32x16 Gt = G1;
                if (tau == 0) { Gt = zero16(); Gt = MFMA32(Ua, gf[0], Gt); Gt = MFMA32(Ub, gf[1], Gt); }
                else if (hh == 0) DEC[32 * dl + r32] = __builtin_amdgcn_exp2f(GL);
                f32x16 t16;
#pragma unroll
                for (int ks = 0; ks < 2; ++ks) { const bf16x8 kfr = trfrag(B + GLA_KOFF + tr_qk + (32 * tau + 16 * ks) * GQS + dl * 64, 8 * GQS);
#pragma unroll
                    for (int j = 0; j < 8; ++j) t16[8 * ks + j] = bfel(kfr, j) * __builtin_amdgcn_exp2f(GL - Gt[8 * ks + j]); }
                fput(L + G2_KTE, (tau * 2 + dl) * 2 + 0, lane, pack8(t16, 0)); fput(L + G2_KTE, (tau * 2 + dl) * 2 + 1, lane, pack8(t16, 1));
            }
            v2u zq[4];
#pragma unroll
            for (int q4 = 0; q4 < 4; ++q4) zq[q4] = *(const v2u*)(F.ZG + (((((size_t)(bh * 32 + c) * 2 + x) * 4 + vb) * 4 + q4) * 32 + r32) * 8 + 4 * hh);
            asm volatile("" ::: "memory");
            v4u st[5];
            if (more) gla_stage_load(Gb + (size_t)(c + 1) * 64 * 320, tid, st);
            G2_SYNC();
            bf16x8 vf[2][2];
#pragma unroll
            for (int tau = 0; tau < 2; ++tau)
#pragma unroll
                for (int ks = 0; ks < 2; ++ks) vf[tau][ks] = trfrag(B + GLA_VOFF + tr_v + (32 * tau + 16 * ks) * GVS + vb * 64, 8 * GVS);
            {
                f32x4 dq[4];
#pragma unroll
                for (int q4 = 0; q4 < 4; ++q4) dq[q4] = *(const LAS f32x4*)(DEC + 32 * x + 8 * q4 + 4 * hh);
#pragma unroll
                for (int e = 0; e < 16; ++e) S[e] *= dq[e >> 2][e & 3];
                bf16x8 kt[2][2];
#pragma unroll
                for (int tau = 0; tau < 2; ++tau)
#pragma unroll
                    for (int ks = 0; ks < 2; ++ks) kt[tau][ks] = fget(L + G2_KTE, (tau * 2 + x) * 2 + ks, lane);
#pragma unroll
                for (int tau = 0; tau < 2; ++tau)
#pragma unroll
                    for (int ks = 0; ks < 2; ++ks) S = MFMA32(kt[tau][ks], vf[tau][ks], S);
                LAS char* sfn = L + (((c + 1) & 1) ? G2_SF1 : G2_SF0);
                fput(sfn, (x * 4 + vb) * 2 + 0, lane, pack8(S, 0)); fput(sfn, (x * 4 + vb) * 2 + 1, lane, pack8(S, 1));
            }
            if (w < 3) {
                const int mu = (w == 1) ? 1 : 0, tau = (w == 0) ? 0 : 1;
                bf16x8 fa[2][2], fb[2][2];
#pragma unroll
                for (int dl = 0; dl < 2; ++dl)
#pragma unroll
                    for (int ks = 0; ks < 2; ++ks) { fa[dl][ks] = fget(L + G2_KIF, (dl * 2 + mu) * 2 + ks, lane); fb[dl][ks] = fget(L + G2_QDF, (dl * 2 + tau) * 2 + ks, lane); }
                f32x16 at = zero16(), at2 = zero16();
                at = MFMA32(fa[0][0], fb[0][0], at); at2 = MFMA32(fa[1][0], fb[1][0], at2); at = MFMA32(fa[0][1], fb[0][1], at); at2 = MFMA32(fa[1][1], fb[1][1], at2);
#pragma unroll
                for (int e = 0; e < 16; ++e) at[e] += at2[e];
                if (w < 2) {
#pragma unroll
                    for (int e = 0; e < 16; ++e) { const int m = (e & 3) + 8 * (e >> 2) + 4 * hh; at[e] = (m <= r32) ? at[e] : 0.f; } }
                fput(L + G2_ATF, w * 2 + 0, lane, pack8(at, 0)); fput(L + G2_ATF, w * 2 + 1, lane, pack8(at, 1));
            }
            G2_SYNC();
            f32x16 o = zero16(), o2 = zero16();
            {
                const LAS char* sfp = L + ((c & 1) ? G2_SF1 : G2_SF0);
                bf16x8 fs[2][2], fq[2][2], fa0, fa1, fa2 = ones, fa3 = ones;
#pragma unroll
                for (int dl = 0; dl < 2; ++dl)
#pragma unroll
                    for (int ks = 0; ks < 2; ++ks) { fs[dl][ks] = fget(sfp, (dl * 4 + vb) * 2 + ks, lane); fq[dl][ks] = fget(L + G2_QDF, (dl * 2 + x) * 2 + ks, lane); }
                if (x == 0) { fa0 = fget(L + G2_ATF, 0, lane); fa1 = fget(L + G2_ATF, 1, lane); }
                else { fa0 = fget(L + G2_ATF, 2, lane); fa1 = fget(L + G2_ATF, 3, lane); fa2 = fget(L + G2_ATF, 4, lane); fa3 = fget(L + G2_ATF, 5, lane); }
                const bf16x8 vx0 = x ? vf[1][0] : vf[0][0], vx1 = x ? vf[1][1] : vf[0][1];
                o = MFMA32(vx0, fa0, o); o2 = MFMA32(fs[0][0], fq[0][0], o2);
                o = MFMA32(vx1, fa1, o); o2 = MFMA32(fs[0][1], fq[0][1], o2);
                if (x == 1) { o = MFMA32(vf[0][0], fa2, o); o = MFMA32(vf[0][1], fa3, o); }
                o2 = MFMA32(fs[1][0], fq[1][0], o2); o2 = MFMA32(fs[1][1], fq[1][1], o2);
#pragma unroll
                for (int e = 0; e < 16; ++e) o[e] += o2[e];
            }
            float ssq = 0.f;
#pragma unroll
            for (int e = 0; e < 16; ++e) ssq += o[e] * o[e];
            ssq += __shfl_xor(ssq, 32);
            if (hh == 0) SS[(c & 1) * 256 + (32 * x + r32) * 4 + vb] = ssq;
            if (more) gla_stage_write(L + ((c + 1) & 1) * GLA_BUF, tid, st);
            G2_SYNC();
            const f32x4 s4 = *(const LAS f32x4*)(SS + (c & 1) * 256 + (32 * x + r32) * 4);
            const float rinv = __builtin_amdgcn_rsqf(((s4[0] + s4[1]) + (s4[2] + s4[3])) * (1.f / 128.f) + RMS_EPS);
            v2u wv[4];
#pragma unroll
            for (int q4 = 0; q4 < 4; ++q4) {
                wv[q4].x = pk2(o[4 * q4] * rinv * gq[q4][0] * bflo(zq[q4].x), o[4 * q4 + 1] * rinv * gq[q4][1] * bfhi(zq[q4].x));
                wv[q4].y = pk2(o[4 * q4 + 2] * rinv * gq[q4][2] * bflo(zq[q4].y), o[4 * q4 + 3] * rinv * gq[q4][3] * bfhi(zq[q4].y)); }
            bf16* op = F.A12 + trow * 1024 + h * 128 + 32 * vb + 8 * hh;
#pragma unroll
            for (int g = 0; g < 4; g += 2) {
                const auto rx = __builtin_amdgcn_permlane32_swap(wv[g].x, wv[g + 1].x, false, false);
                const auto ry = __builtin_amdgcn_permlane32_swap(wv[g].y, wv[g + 1].y, false, false);
                *(v4u*)(op + 8 * g) = (v4u){(unsigned)rx[0], (unsigned)ry[0], (unsigned)rx[1], (unsigned)ry[1]}; }
        }
    }
}
__device__ __forceinline__ void p0_xpass(Frame& F) {
    const int lane = F.lane, w = F.wave, tok = lane & 31, hh = lane >> 5;
    constexpr int XT_ROWB = 2064;
    LAS float* RED = (LAS float*)(F.lds + RING_OFF + 67584);
    bf16x8 w1f[8];
#pragma unroll
    for (int s = 0; s < 8; ++s) { float v[8];
#pragma unroll
        for (int j = 0; j < 8; ++j) v[j] = (tok < 16) ? F.w_in[(size_t)(128 * w + 16 * s + 8 * hh + j) * D_IN + 1024 + tok] : 0.f;
        v4u o; o.x = pk2(v[0], v[1]); o.y = pk2(v[2], v[3]); o.z = pk2(v[4], v[5]); o.w = pk2(v[6], v[7]); w1f[s] = __builtin_bit_cast(bf16x8, o); }
    bf16x8 w2f;
    { float v[8];
#pragma unroll
      for (int j = 0; j < 8; ++j) v[j] = F.w_gk2[(4 * hh + (j & 3) + 8 * (j >> 2)) * 256 + 32 * w + tok];
      v4u o; o.x = pk2(v[0], v[1]); o.y = pk2(v[2], v[3]); o.z = pk2(v[4], v[5]); o.w = pk2(v[6], v[7]); w2f = __builtin_bit_cast(bf16x8, o); }
    f32x4 bq[4];
#pragma unroll
    for (int q4 = 0; q4 < 4; ++q4) bq[q4] = *(const f32x4*)(F.b_gk + 32 * w + 8 * q4 + 4 * hh);
    const int crow0 = F.tid >> 7, ckc = F.tid & 127;
    LAS char* XT = (LAS char*)(F.lds + RING_OFF);
    f32x4 ld[4][2];
    { const float* xp = F.x + ((size_t)F.vcu * 16 + crow0) * D + 8 * ckc;
#pragma unroll
      for (int i = 0; i < 4; ++i) { ld[i][0] = __builtin_nontemporal_load((const GAS f32x4*)(xp + (size_t)i * 4 * D)); ld[i][1] = __builtin_nontemporal_load((const GAS f32x4*)(xp + (size_t)i * 4 * D + 4)); } }
    for (int blk = F.vcu; blk < M / 16; blk += F.G) {
        { bf16* xb = F.XB + ((size_t)blk * 16 + crow0) * D + 8 * ckc;
#pragma unroll
          for (int i = 0; i < 4; ++i) { v4u o; o.x = pk2(ld[i][0][0], ld[i][0][1]); o.y = pk2(ld[i][0][2], ld[i][0][3]); o.z = pk2(ld[i][1][0], ld[i][1][1]); o.w = pk2(ld[i][1][2], ld[i][1][3]);
              *(GAS v4u*)(xb + (size_t)i * 4 * D) = o; *(LAS v4u*)(XT + (crow0 + 4 * i) * XT_ROWB + ckc * 16) = o; } }
        if (blk + F.G < M / 16) { const float* xp = F.x + ((size_t)(blk + F.G) * 16 + crow0) * D + 8 * ckc;
#pragma unroll
            for (int i = 0; i < 4; ++i) { ld[i][0] = __builtin_nontemporal_load((const GAS f32x4*)(xp + (size_t)i * 4 * D)); ld[i][1] = __builtin_nontemporal_load((const GAS f32x4*)(xp + (size_t)i * 4 * D + 4)); } }
        __syncthreads();
        f32x16 acc = zero16();
        { bf16x8 xf[8];
#pragma unroll
          for (int s = 0; s < 8; ++s) xf[s] = *(const LAS bf16x8*)(XT + (tok & 15) * XT_ROWB + (128 * w + 16 * s + 8 * hh) * 2);
#pragma unroll
          for (int s = 0; s < 8; ++s) acc = MFMA32(w1f[s], xf[s], acc); }
        LAS float* red = RED;
#pragma unroll
        for (int e = 0; e < 8; ++e) red[w * 512 + ((e & 3) + 8 * (e >> 2) + 4 * hh) * 32 + tok] = acc[e];
        __syncthreads();
        float r[8];
#pragma unroll
        for (int j = 0; j < 8; ++j) { const LAS float* q = red + ((j & 3) + 8 * (j >> 2) + 4 * hh) * 32 + tok;
            r[j] = ((q[0] + q[512]) + (q[1024] + q[1536])) + ((q[2048] + q[2560]) + (q[3072] + q[3584])); }
        v4u hi, lo;
        hi.x = pk2(r[0], r[1]); hi.y = pk2(r[2], r[3]); hi.z = pk2(r[4], r[5]); hi.w = pk2(r[6], r[7]);
        lo.x = pk2(r[0] - bflo(hi.x), r[1] - bfhi(hi.x)); lo.y = pk2(r[2] - bflo(hi.y), r[3] - bfhi(hi.y)); lo.z = pk2(r[4] - bflo(hi.z), r[5] - bfhi(hi.z)); lo.w = pk2(r[6] - bflo(hi.w), r[7] - bfhi(hi.w));
        f32x16 lg = zero16();
        lg = MFMA32(w2f, __builtin_bit_cast(bf16x8, hi), lg); lg = MFMA32(w2f, __builtin_bit_cast(bf16x8, lo), lg);
        v2u wv[4];
#pragma unroll
        for (int q4 = 0; q4 < 4; ++q4) {
            wv[q4].x = pk2(pg8::t_lg2(lg[4 * q4] + bq[q4][0]), pg8::t_lg2(lg[4 * q4 + 1] + bq[q4][1]));
            wv[q4].y = pk2(pg8::t_lg2(lg[4 * q4 + 2] + bq[q4][2]), pg8::t_lg2(lg[4 * q4 + 3] + bq[q4][3])); }
        const int m = blk * 16 + (tok & 15);
        bf16* op = F.HG + ((size_t)((m >> 11) * 4 + (w >> 1)) * SEQ + (m & (SEQ - 1))) * 320 + 128 + 32 * (w & 1) + 8 * hh;
#pragma unroll
        for (int g = 0; g < 4; g += 2) {
            const auto rx = __builtin_amdgcn_permlane32_swap(wv[g].x, wv[g + 1].x, false, false);
            const auto ry = __builtin_amdgcn_permlane32_swap(wv[g].y, wv[g + 1].y, false, false);
            if (tok < 16) *(v4u*)(op + 8 * g) = (v4u){(unsigned)rx[0], (unsigned)ry[0], (unsigned)rx[1], (unsigned)ry[1]}; }
    }
    __syncthreads();
}
__device__ __forceinline__ void ln_rows(Frame& F) {
    const int gw = F.vcu * NWAVES + F.wave, NGW = F.G * NWAVES;
    f32x4 gv[4], bv[4];
#pragma unroll
    for (int j = 0; j < 4; ++j) { gv[j] = *((const f32x4*)F.ln_g + F.lane + 64 * j); bv[j] = *((const f32x4*)F.ln_b + F.lane + 64 * j); }
    for (int m = gw; m < M; m += NGW) {
        GAS f32x4* xr = (GAS f32x4*)(F.out + (size_t)m * D) + F.lane;
        const GAS v2u* xi = (const GAS v2u*)(F.XB + (size_t)m * D) + F.lane; const GAS v2u* yi = (const GAS v2u*)(F.Yb + (size_t)m * D) + F.lane;
        f32x4 v[4]; float s = 0.f;
#pragma unroll
        for (int j = 0; j < 4; ++j) { const v2u xw = __builtin_nontemporal_load(xi + 64 * j); const f32x4 xv = {bflo(xw.x), bfhi(xw.x), bflo(xw.y), bfhi(xw.y)}; const v2u yw = __builtin_nontemporal_load(yi + 64 * j);
            v[j] = xv * ALPHA + (f32x4){bflo(yw.x), bfhi(yw.x), bflo(yw.y), bfhi(yw.y)}; s += (v[j].x + v[j].y) + (v[j].z + v[j].w); }
        const float mean = wave_sum(s) * (1.f / D); float s2 = 0.f;
#pragma unroll
        for (int j = 0; j < 4; ++j) { v[j] = v[j] - mean; s2 += (v[j].x * v[j].x + v[j].y * v[j].y) + (v[j].z * v[j].z + v[j].w * v[j].w); }
        const float rstd = __builtin_amdgcn_rsqf(wave_sum(s2) * (1.f / D) + LN_EPS);
#pragma unroll
        for (int j = 0; j < 4; ++j) xr[64 * j] = v[j] * rstd * gv[j] + bv[j];
    }
}

struct Args { const float* in[12]; float* out; unsigned char* ws; int ph_lo, ph_hi, li, pad; };
__global__ void __launch_bounds__(NWAVES * 64, 2) mk_fwd(Args args) {
    extern __shared__ __attribute__((aligned(16))) unsigned char lds[];
    Frame F;
    F.lds = (LAS unsigned char*)lds;
    F.MISC = (volatile LAS unsigned*)(F.lds + MISC_OFF);
    F.tid = threadIdx.x; F.lane = F.tid & 63; F.wave = __builtin_amdgcn_readfirstlane(F.tid >> 6);
    F.G = gridDim.x; { const int bx = blockIdx.x; F.vcu = (F.G % 8 == 0) ? (bx % 8) * (F.G / 8) + bx / 8 : bx; }
#define GRID_BAR(seam) do { if (N_LAUNCHES == PER_PHASE) { if (F.tid == 0) __hip_atomic_store(F.ctl + CW_TMO, 0xBADBA0u | (unsigned)(seam), RLX_AGENT); } \
    else { xcd_barrier(bar); } } while (0)
    unsigned char* ws = args.ws;
    F.ctl = (gu32*)(ws + WS_CTL);
    F.x = args.in[0]; F.w_in = args.in[1]; F.w_gk2 = args.in[2]; F.b_gk = args.in[3]; F.gla_norm_g = args.in[4]; F.w_o_gla = args.in[5];
    F.sinks = args.in[6]; F.w_o_swa = args.in[7]; F.b_gate = args.in[8]; F.w_out = args.in[9]; F.ln_g = args.in[10]; F.ln_b = args.in[11]; F.out = args.out;
    F.Win_t = (bf16*)(ws + WS_WIN); F.Wo12_t = (bf16*)(ws + WS_WO12); F.Wout_t = (bf16*)(ws + WS_WOUT);
    F.XB = (bf16*)(ws + WS_XB); F.A12 = (bf16*)(ws + WS_A12); F.H = (bf16*)(ws + WS_H); F.Mm = (bf16*)(ws + WS_MM); F.G8 = ws + WS_G8; F.HG = (bf16*)(ws + WS_HG); F.ZG = (bf16*)(ws + WS_ZG); F.ZS = (bf16*)(ws + WS_ZS); F.QS = (bf16*)(ws + WS_QS); F.Yb = (bf16*)(ws + WS_A12);
    for (int u = F.tid; u < (LDS_BYTES - LDSCTL_OFF) / 4; u += NWAVES * 64) ((LAS unsigned*)(F.lds + LDSCTL_OFF))[u] = 0u;
    __syncthreads();
    XcdBarrier bar; bar.bar = (unsigned*)(F.ctl + CW_BAR); bar.x = 0; bar.st = nullptr;
    if (N_LAUNCHES != PER_PHASE) bar = xcd_barrier_post((unsigned*)(F.ctl + CW_BAR), F.MISC + 8);
    const int lo = args.ph_lo, hi = args.ph_hi;
#define IN(k) (lo <= (k) && (k) < hi)
#define BOTH(k) (IN(k) && IN((k) + 1))

    if (IN(0)) { p0_xpass(F); p0_prologue(F); if (BOTH(0)) GRID_BAR(0); }

    if (IN(1)) {
        pg8::Gemm g{F.XB, F.Win_t, D, D, D}; pg8::SkipOrder S; S.init(M, pg8::NP1, F.G, (int)blockIdx.x, 2);
        pg8::Epi1 E{F.H, F.b_gk, F.b_gate, F.G8, F.HG, F.ZG, F.ZS, F.QS};
        pg8::gemm_phase<pg8::Epi1, pg8::SkipOrder, true, true>(F.lds + RING_OFF, g, S, E);
        if (BOTH(1)) GRID_BAR(1);
    }
    if (IN(2)) {
        gla_mfma2(F, F.G < 128 ? F.G : 128);
        __syncthreads();
        swa_mfma(F);
        if (BOTH(2)) GRID_BAR(2);
    }
    if (IN(3)) {
        pg8::Gemm g{F.A12, F.Wo12_t, 1024, 512, 512}; pg8::PairOrder S; S.init(M, D, F.G, (int)blockIdx.x);
        pg8::Epi3 E{F.Mm, F.G8};
        pg8::gemm_phase<pg8::Epi3, pg8::PairOrder, true, true>(F.lds + RING_OFF, g, S, E);
        if (BOTH(3)) GRID_BAR(3);
    }
    if (IN(4)) {
        pg8::Gemm g{F.Mm, F.Wout_t, D, D, D}; pg8::StaticOrder S; S.init(M, D, F.G, (int)blockIdx.x);
        pg8::Epi4 E{F.Yb};
        pg8::gemm_phase<pg8::Epi4, pg8::StaticOrder, true, true>(F.lds + RING_OFF, g, S, E);
        if (BOTH(4)) GRID_BAR(4);
    }
    if (IN(5)) { ln_rows(F); }
#undef IN
#undef BOTH
}

extern "C" void kernel_launch(void* const* d_in, const int* in_sizes, int n_in, void* d_out, int out_size, void* d_ws, size_t ws_size, hipStream_t stream) {
    static int grid = 0;
    if (grid == 0) {
        if (n_in != 12 || in_sizes[0] != M * D || out_size != M * D || ws_size < WS_END) { fprintf(stderr, "kernel_launch: unexpected shapes (n_in %d, in0 %d, out %d, ws %zu); nothing launched\n", n_in, n_in > 0 ? in_sizes[0] : -1, out_size, ws_size); grid = -1; return; }
        int dev = 0, cus = 0, per_cu = 0;
        if (hipGetDevice(&dev) != hipSuccess || hipDeviceGetAttribute(&cus, hipDeviceAttributeMultiprocessorCount, dev) != hipSuccess) { grid = -1; return; }
        if (hipFuncSetAttribute((const void*)mk_fwd, hipFuncAttributeMaxDynamicSharedMemorySize, LDS_BYTES) != hipSuccess) { fprintf(stderr, "kernel_launch: hipFuncSetAttribute failed\n"); grid = -1; return; }
        if (hipOccupancyMaxActiveBlocksPerMultiprocessor(&per_cu, (const void*)mk_fwd, NWAVES * 64, LDS_BYTES) != hipSuccess || per_cu < 1)
            fprintf(stderr, "kernel_launch: note: occupancy query reports %d workgroups per CU\n", per_cu);
        (void)hipGetLastError();
        grid = cus;
    }
    if (grid < 0) return;
    if (hipMemsetAsync((char*)d_ws + WS_CTL, 0, CTL_ZERO_BYTES, stream) != hipSuccess) { fprintf(stderr, "kernel_launch: hipMemsetAsync failed\n"); return; }
    Args a{};
    for (int i = 0; i < 12; ++i) a.in[i] = (const float*)d_in[i];
    a.out = (float*)d_out; a.ws = (unsigned char*)d_ws;
    for (int li = 0; li < N_LAUNCHES; ++li) {
        a.ph_lo = (N_LAUNCHES == PER_PHASE) ? li : 0; a.ph_hi = (N_LAUNCHES == PER_PHASE) ? li + 1 : PER_PHASE; a.li = li;
        hipLaunchKernelGGL(mk_fwd, dim3(grid), dim3(NWAVES * 64), LDS_BYTES, stream, a);
        const hipError_t le = hipPeekAtLastError();
        if (le != hipSuccess) { fprintf(stderr, "kernel_launch: launch %d failed: %s\n", li, hipGetErrorName(le)); break; }
    }
}
```
